# Optimizing an MI355X kernel written in HIP

```python
import jax, jax.numpy as jnp
from jax import lax
import numpy as np

D_MODEL = 1024
BATCH = 8
SEQ = 2048
DEPTH = 1
DEC_BATCH = 32
DEC_SEQ = 4
PAST_LEN = 8192
PAGE_SIZE = 128

D_PLE = 256
A_GROUPS = 4
A_WIDTH = 128
A_CHUNK = 128
A_DIM = A_GROUPS * A_WIDTH
B_HEADS = 8
B_HEAD_DIM = 64
B_DIM = B_HEADS * B_HEAD_DIM
MOBA_BLOCK = 256
MOBA_TOPK = 3
Q_BLOCK = 64
D_FF = 4 * D_MODEL
IN_DIM = 2 * A_DIM + 3 * B_DIM
EPS = 1e-6

kernel_name = "hymba_gmlp_moba_decode_step"


def rms_norm(x, g):
    xf = x.astype(jnp.float32)
    y = xf * lax.rsqrt(jnp.mean(xf * xf, axis=-1, keepdims=True) + EPS)
    return (y * g.astype(jnp.float32)).astype(x.dtype)


def in_projection(hn, w_in, a_v_norm, q_norm, k_norm):
    z = hn @ w_in
    u, va, q, k, vb = jnp.split(z, [A_DIM, 2 * A_DIM, 2 * A_DIM + B_DIM, 2 * A_DIM + 2 * B_DIM], axis=-1)
    lead = hn.shape[:-1]
    u = jax.nn.gelu(u).reshape(*lead, A_GROUPS, A_WIDTH)
    va = rms_norm(jax.nn.gelu(va).reshape(*lead, A_GROUPS, A_WIDTH), a_v_norm)
    q = rms_norm(q.reshape(*lead, B_HEADS, B_HEAD_DIM), q_norm)
    k = rms_norm(k.reshape(*lead, B_HEADS, B_HEAD_DIM), k_norm)
    vb = vb.reshape(*lead, B_HEADS, B_HEAD_DIM)
    return u, va, q, k, vb


def spatial_gate_prompt(u, va, ws, bs):
    b, s = u.shape[:2]
    nc = s // A_CHUNK
    w = jnp.tril(ws)
    vc = va.reshape(b, nc, A_CHUNK, A_GROUPS, A_WIDTH)
    sg = jnp.einsum('gts,bcsgw->bctgw', w, vc) + bs.T[:, :, None]
    return (u * sg.reshape(b, s, A_GROUPS, A_WIDTH)).reshape(b, s, A_DIM)


def spatial_gate_sample(u, va, ws, bs):
    b, n = u.shape[:2]
    w = jnp.tril(ws)[:, :n, :n]
    sg = jnp.einsum('gts,bsgw->btgw', w, va) + bs[:, :n].T[:, :, None]
    return (u * sg).reshape(b, n, A_DIM)


def to_blocks(x):
    b, l = x.shape[:2]
    nb = -(-l // MOBA_BLOCK)
    x = jnp.pad(x, ((0, 0), (0, nb * MOBA_BLOCK - l), (0, 0), (0, 0)))
    return x.reshape(b, nb, MOBA_BLOCK, B_HEADS, B_HEAD_DIM).transpose(0, 3, 1, 2, 4)


def moba_queries(q, t, kb, vb, kmean):
    b, h, nq, d = q.shape
    nb = kb.shape[2]
    k_sel = min(MOBA_TOPK, nb)
    n_past = t // MOBA_BLOCK
    gate = jnp.einsum('bhqd,bhnd->bhqn', q.astype(jnp.float32), kmean)
    past = jnp.arange(nb)[None, :] < n_past[:, None]
    gate = jnp.where(past[None, None], gate, -jnp.inf)
    _, top = lax.top_k(gate, k_sel)
    own = jnp.broadcast_to(n_past[None, None, :, None], (b, h, nq, 1)).astype(top.dtype)
    sel = jnp.concatenate([top, own], axis=-1)
    slot = jnp.arange(k_sel + 1)
    slot_ok = (slot[None, :] < n_past[:, None]) | (slot[None, :] == k_sel)
    bi = jnp.arange(b)[:, None, None, None]
    hi = jnp.arange(h)[None, :, None, None]
    kg = kb[bi, hi, sel]
    vg = vb[bi, hi, sel]
    pos = sel[..., None] * MOBA_BLOCK + jnp.arange(MOBA_BLOCK)
    mask = slot_ok[None, None, :, :, None] & (pos <= t[None, None, :, None, None])
    s = jnp.einsum('bhqd,bhqnkd->bhqnk', q, kg).astype(jnp.float32) * (d ** -0.5)
    s = jnp.where(mask, s, -jnp.inf)
    p = jax.nn.softmax(s.reshape(b, h, nq, -1), axis=-1).reshape(s.shape).astype(vg.dtype)
    return jnp.einsum('bhqnk,bhqnkd->bhqd', p, vg)


def moba_prompt(q, k, v):
    b, s = q.shape[:2]
    kb, vb = to_blocks(k), to_blocks(v)
    kmean = jnp.mean(kb.astype(jnp.float32), axis=3)
    qt = q.transpose(0, 2, 1, 3)
    nc = s // Q_BLOCK

    def chunk(c):
        start = c * Q_BLOCK
        qc = lax.dynamic_slice_in_dim(qt, start, Q_BLOCK, axis=2)
        t = start + jnp.arange(Q_BLOCK, dtype=jnp.int32)
        return moba_queries(qc, t, kb, vb, kmean)

    o = lax.map(chunk, jnp.arange(nc, dtype=jnp.int32))
    return o.transpose(1, 0, 3, 2, 4).reshape(b, s, B_DIM)


def moba_sample(q, k, v, cache_k, cache_v, page_table):
    db, n = q.shape[:2]
    past_k = cache_k[page_table].reshape(db, -1, B_HEADS, B_HEAD_DIM).astype(k.dtype)
    past_v = cache_v[page_table].reshape(db, -1, B_HEADS, B_HEAD_DIM).astype(v.dtype)
    past_len = past_k.shape[1]
    kb = to_blocks(jnp.concatenate([past_k, k], axis=1))
    vb = to_blocks(jnp.concatenate([past_v, v], axis=1))
    kmean = jnp.mean(kb.astype(jnp.float32), axis=3)
    t = past_len + jnp.arange(n, dtype=jnp.int32)
    o = moba_queries(q.transpose(0, 2, 1, 3), t, kb, vb, kmean)
    return o.transpose(0, 2, 1, 3).reshape(db, n, B_DIM)


def channel_and_ple(h, p, ln2, w_up, w_down, ln3, w_ple_gate, w_ple_proj, ple_norm):
    h = h + jnp.square(jax.nn.relu(rms_norm(h, ln2) @ w_up)) @ w_down
    gate = jax.nn.sigmoid(rms_norm(h, ln3) @ w_ple_gate)
    e = rms_norm(p @ w_ple_proj, ple_norm)
    return h + gate * e


def setup_inputs(seed: int = 0) -> dict:
    key = jax.random.key(seed)
    ks = jax.random.split(key, 24)
    n_pages = PAST_LEN // PAGE_SIZE
    n_used = DEC_BATCH * n_pages
    n_pool = n_used + (n_used + 3) // 4
    f32 = jnp.float32
    nrm = lambda k, shp, sc: jax.random.normal(k, shp, f32) * sc
    gain = lambda k, shp: 1.0 + 0.05 * jax.random.normal(k, shp, f32)
    page_table = jax.random.permutation(ks[6], n_pool)[:n_used].reshape(DEC_BATCH, n_pages).astype(jnp.int32)
    return {
        "x_prompt": nrm(ks[0], (BATCH, SEQ, D_MODEL), 1.0),
        "x_sample": nrm(ks[1], (DEC_BATCH, DEC_SEQ, D_MODEL), 1.0),
        "p_prompt": nrm(ks[2], (DEPTH, BATCH, SEQ, D_PLE), 1.0),
        "p_sample": nrm(ks[3], (DEPTH, DEC_BATCH, DEC_SEQ, D_PLE), 1.0),
        "cache_k": nrm(ks[4], (DEPTH, n_pool, PAGE_SIZE, B_HEADS, B_HEAD_DIM), 1.0),
        "cache_v": nrm(ks[5], (DEPTH, n_pool, PAGE_SIZE, B_HEADS, B_HEAD_DIM), 1.0),
        "page_table": page_table,
        "ln1": gain(ks[7], (DEPTH, D_MODEL)),
        "w_in": nrm(ks[8], (DEPTH, D_MODEL, IN_DIM), D_MODEL ** -0.5),
        "a_v_norm": gain(ks[9], (DEPTH, A_GROUPS, A_WIDTH)),
        "a_ws": nrm(ks[10], (DEPTH, A_GROUPS, A_CHUNK, A_CHUNK), A_CHUNK ** -0.5),
        "a_bs": gain(ks[11], (DEPTH, A_GROUPS, A_CHUNK)),
        "q_norm": gain(ks[12], (DEPTH, B_HEAD_DIM)),
        "k_norm": gain(ks[13], (DEPTH, B_HEAD_DIM)),
        "w_out": nrm(ks[14], (DEPTH, A_DIM + B_DIM, D_MODEL), (A_DIM + B_DIM) ** -0.5),
        "ln2": gain(ks[15], (DEPTH, D_MODEL)),
        "w_up": nrm(ks[16], (DEPTH, D_MODEL, D_FF), D_MODEL ** -0.5),
        "w_down": nrm(ks[17], (DEPTH, D_FF, D_MODEL), D_FF ** -0.5),
        "ln3": gain(ks[18], (DEPTH, D_MODEL)),
        "w_ple_gate": nrm(ks[19], (DEPTH, D_MODEL, D_MODEL), D_MODEL ** -0.5),
        "w_ple_proj": nrm(ks[20], (DEPTH, D_PLE, D_MODEL), D_PLE ** -0.5),
        "ple_norm": gain(ks[21], (DEPTH, D_MODEL)),
    }


def reference(x_prompt, x_sample, p_prompt, p_sample, cache_k, cache_v, page_table,
              ln1, w_in, a_v_norm, a_ws, a_bs, q_norm, k_norm, w_out,
              ln2, w_up, w_down, ln3, w_ple_gate, w_ple_proj, ple_norm):
    hp, hs = x_prompt, x_sample
    kp_l, vp_l, ks_l, vs_l, as_l = [], [], [], [], []
    for i in range(DEPTH):
        u, va, q, k, v = in_projection(rms_norm(hp, ln1[i]), w_in[i], a_v_norm[i], q_norm[i], k_norm[i])
        mix = jnp.concatenate([spatial_gate_prompt(u, va, a_ws[i], a_bs[i]), moba_prompt(q, k, v)], axis=-1)
        hp = channel_and_ple(hp + mix @ w_out[i], p_prompt[i], ln2[i], w_up[i], w_down[i],
                             ln3[i], w_ple_gate[i], w_ple_proj[i], ple_norm[i])
        kp_l.append(k)
        vp_l.append(v)
        u, va, q, k, v = in_projection(rms_norm(hs, ln1[i]), w_in[i], a_v_norm[i], q_norm[i], k_norm[i])
        mix = jnp.concatenate([spatial_gate_sample(u, va, a_ws[i], a_bs[i]),
                               moba_sample(q, k, v, cache_k[i], cache_v[i], page_table)], axis=-1)
        hs = channel_and_ple(hs + mix @ w_out[i], p_sample[i], ln2[i], w_up[i], w_down[i],
                             ln3[i], w_ple_gate[i], w_ple_proj[i], ple_norm[i])
        ks_l.append(k)
        vs_l.append(v)
        as_l.append(va)
    k_prompt_new = jnp.stack(kp_l)
    v_prompt_new = jnp.stack(vp_l)
    k_sample_new = jnp.stack(ks_l)
    v_sample_new = jnp.stack(vs_l)
    state_a_v_sample = jnp.stack(as_l)
    return (hp, hs, k_prompt_new, v_prompt_new, k_sample_new, v_sample_new, state_a_v_sample)
```

```cpp
#include <hip/hip_runtime.h>
#include <cstdio>
#include <cstdint>
namespace pg8 {
#define PG8_LAS __attribute__((address_space(3)))
typedef unsigned short bf16_t;
typedef short bf16x8 __attribute__((ext_vector_type(8)));
typedef float f32x4 __attribute__((ext_vector_type(4)));
typedef unsigned u32x4 __attribute__((ext_vector_type(4)));
constexpr int BM = 256, BK = 64, HALF = 128, HTB = HALF * BK * 2  , STAGE_BYTES = 8 * HTB, NXCD = 8, WGM = 8;

__host__ __device__ __forceinline__ int lds_byte(int r, int c) { const int st = (r >> 4) * 2 + (c >> 5), rr = r & 15, cc = c & 31, ob = rr * 64 + cc * 2; return st * 1024 + (ob ^ (((ob >> 9) & 1) << 5)); }
__host__ __device__ __forceinline__ void stage_rc(int b, int& R, int& C) { const int st = b / 1024, sb = b % 1024, swz = sb ^ (((sb >> 9) & 1) << 5); R = (st >> 1) * 16 + swz / 64; C = (st & 1) * 32 + (swz % 64) / 2; }
__host__ __device__ __forceinline__ int perm32(int rho) { const int n = rho >> 4, i = rho & 15; return 8 * (i >> 2) + 4 * n + (i & 3); }

struct Unit { int pm, pn; };
struct Gemm { const bf16_t* A; const bf16_t* Bt; int M, N, K; };

struct StaticOrder {
    int nM, nN, nwg, G, c;
    __host__ __device__ void init(int M, int N, int G_, int c_) { nM = M / BM; nN = N / BM; nwg = nM * nN; G = G_; c = c_; }
    __host__ __device__ bool next(int i, Unit& u) const {
        const long L = (long)i * G + c; if (L >= nwg) return false;
        int wgid = (int)L; { const int q = nwg / NXCD, r = nwg % NXCD, xcd = wgid % NXCD, off = wgid / NXCD; wgid = (xcd < r ? xcd * (q + 1) : r * (q + 1) + (xcd - r) * q) + off; }
        const int nig = WGM * nN, gid = wgid / nig, fm = gid * WGM, gsz = (nM - fm) < WGM ? (nM - fm) : WGM;
        u.pm = fm + ((wgid % nig) % gsz); u.pn = (wgid % nig) / gsz; return true;
    }
    __device__ __forceinline__ void a_ready(const Unit&) const {}
    __device__ __forceinline__ void done(const Unit&) const {}
};

__device__ __forceinline__ unsigned cvt_pk_bf16(float lo, float hi) { unsigned r; asm volatile("v_cvt_pk_bf16_f32 %0, %1, %2" : "=v"(r) : "v"(lo), "v"(hi)); return r; }
typedef float f32x2 __attribute__((ext_vector_type(2)));
__device__ __forceinline__ f32x2 gelu_pk(f32x2 v) {
    const f32x2 av = __builtin_elementwise_abs(v), d = av * 0.2316418882f + 1.0f;
    f32x2 t; t.x = __builtin_amdgcn_rcpf(d.x); t.y = __builtin_amdgcn_rcpf(d.y);
    f32x2 q = t * 0.5307027145f + (-0.7265760135f); q = q * t + 0.7107068705f; q = q * t + (-0.142248368f); q = q * t + 0.127414796f; q = q * t;
    const f32x2 s = (v * v) * (-0.72134752044f);
    f32x2 e; e.x = __builtin_amdgcn_exp2f(s.x); e.y = __builtin_amdgcn_exp2f(s.y);
    const f32x2 m = v * (q * e), r = v - m;
    f32x2 o; o.x = v.x < 0.f ? m.x : r.x; o.y = v.y < 0.f ? m.y : r.y; return o;
}

typedef float f32x2 __attribute__((ext_vector_type(2)));
typedef unsigned u32x2 __attribute__((ext_vector_type(2)));
__device__ __forceinline__ float gelu_t(float x) {
    const float u = x * (1.5957691216f + 0.0713548163f * x * x);
    const float e = __builtin_amdgcn_exp2f(-1.4426950408889634f * u);
    return x * __builtin_amdgcn_rcpf(1.0f + e);
}
__device__ __forceinline__ f32x4 gelu4(f32x4 v) { return (f32x4){gelu_t(v[0]), gelu_t(v[1]), gelu_t(v[2]), gelu_t(v[3])}; }
__device__ __forceinline__ u32x4 pack8(f32x4 a, f32x4 b) { u32x4 w; w.x = cvt_pk_bf16(a[0], a[1]); w.y = cvt_pk_bf16(a[2], a[3]); w.z = cvt_pk_bf16(b[0], b[1]); w.w = cvt_pk_bf16(b[2], b[3]); return w; }
__device__ __forceinline__ float dot4(f32x4 a, f32x4 b) { return (a[0] * b[0] + a[1] * b[1]) + (a[2] * b[2] + a[3] * b[3]); }
__device__ __forceinline__ f32x4 bf4_to_f32(u32x2 w) { return (f32x4){__uint_as_float(w.x << 16), __uint_as_float(w.x & 0xffff0000u), __uint_as_float(w.y << 16), __uint_as_float(w.y & 0xffff0000u)}; }

struct EpiIn {
    static constexpr bool PERM = true, AFTER_DRAIN = false;
    bf16_t *U, *VA, *Q, *K, *V; float *kout, *vout, *kmp; const float *qn, *kn; float c2, eps;
    __device__ __forceinline__ void operator()(const f32x4 (&acc)[2][2][4][2], const Unit& u, int wr, int wc, int fr, int fq) const {
        const int sec = u.pn >> 1;
        const int cs0 = (u.pn & 1) * 256 + wc * 64 + fq * 8;
        const int rowb = u.pm * BM + wr * 64 + fr;
#ifndef SECM
#define SECM 7
#endif
        if ((SECM & 1) && sec < 2) {
            bf16_t* O = sec == 0 ? U : VA;
#pragma unroll
            for (int ai = 0; ai < 2; ++ai)
#pragma unroll
                for (int m = 0; m < 4; ++m) { bf16_t* rowp = O + (size_t)(rowb + ai * HALF + m * 16) * 512 + cs0;
#pragma unroll
                    for (int bj = 0; bj < 2; ++bj) *(u32x4*)(rowp + 32 * bj) = pack8(gelu4(acc[ai][bj][m][0]), gelu4(acc[ai][bj][m][1])); }
        } else if ((SECM & 2) && sec == 4) {
#pragma unroll
            for (int ai = 0; ai < 2; ++ai)
#pragma unroll
                for (int m = 0; m < 4; ++m) { const size_t off = (size_t)(rowb + ai * HALF + m * 16) * 512 + cs0;
#pragma unroll
                    for (int bj = 0; bj < 2; ++bj) { const f32x4 v0 = acc[ai][bj][m][0], v1 = acc[ai][bj][m][1];
                        *(u32x4*)(V + off + 32 * bj) = pack8(v0, v1); *(f32x4*)(vout + off + 32 * bj) = v0; *(f32x4*)(vout + off + 32 * bj + 4) = v1; } }
        } else if (SECM & 4) {
            const float* gn = sec == 2 ? qn : kn; const float sc = sec == 2 ? c2 : 1.0f;
            f32x4 g[2][2], ks[2][2];
#pragma unroll
            for (int bj = 0; bj < 2; ++bj)
#pragma unroll
                for (int n = 0; n < 2; ++n) { g[bj][n] = *(const f32x4*)(gn + 32 * bj + 8 * fq + 4 * n) * sc; ks[bj][n] = (f32x4){0.f, 0.f, 0.f, 0.f}; }
#pragma unroll
            for (int ai = 0; ai < 2; ++ai)
#pragma unroll
                for (int m = 0; m < 4; ++m) {
                    float ss = (dot4(acc[ai][0][m][0], acc[ai][0][m][0]) + dot4(acc[ai][0][m][1], acc[ai][0][m][1])) + (dot4(acc[ai][1][m][0], acc[ai][1][m][0]) + dot4(acc[ai][1][m][1], acc[ai][1][m][1]));
                    ss += __shfl_xor(ss, 16); ss += __shfl_xor(ss, 32);
                    const float rstd = 1.0f / sqrtf(ss * (1.0f / 64.0f) + eps);
                    const size_t off = (size_t)(rowb + ai * HALF + m * 16) * 512 + cs0;
#pragma unroll
                    for (int bj = 0; bj < 2; ++bj) { const f32x4 o0 = acc[ai][bj][m][0] * rstd * g[bj][0], o1 = acc[ai][bj][m][1] * rstd * g[bj][1];
                        if (sec == 2) { *(u32x4*)(Q + off + 32 * bj) = pack8(o0, o1); }
                        else { *(u32x4*)(K + off + 32 * bj) = pack8(o0, o1); *(f32x4*)(kout + off + 32 * bj) = o0; *(f32x4*)(kout + off + 32 * bj + 4) = o1; ks[bj][0] += o0; ks[bj][1] += o1; } }
                }
            if (sec == 3) {
#pragma unroll
                for (int bj = 0; bj < 2; ++bj)
#pragma unroll
                    for (int n = 0; n < 2; ++n) { f32x4 s = ks[bj][n];
#pragma unroll
                        for (int e = 0; e < 4; ++e) { float x = s[e]; x += __shfl_xor(x, 1); x += __shfl_xor(x, 2); x += __shfl_xor(x, 4); x += __shfl_xor(x, 8); s[e] = x; }
                        if (fr == 0) *(f32x4*)(kmp + (size_t)(u.pm * 2 + wr) * 512 + cs0 + 32 * bj + 4 * n) = s; }
            }
        }
    }
};
struct EpiE {
    static constexpr bool PERM = true, AFTER_DRAIN = false;
    bf16_t* ER; float* sse;
    __device__ __forceinline__ void operator()(const f32x4 (&acc)[2][2][4][2], const Unit& u, int wr, int wc, int fr, int fq) const {
        const int col0 = u.pn * BM + wc * 32 + 8 * fq, rowb = u.pm * BM + wr * 64 + fr;
#pragma unroll
        for (int ai = 0; ai < 2; ++ai)
#pragma unroll
            for (int m = 0; m < 4; ++m) { const int row = rowb + ai * HALF + m * 16; float ss = 0.f;
#pragma unroll
                for (int bj = 0; bj < 2; ++bj) { const f32x4 v0 = acc[ai][bj][m][0], v1 = acc[ai][bj][m][1]; ss += dot4(v0, v0) + dot4(v1, v1);
                    *(u32x4*)(ER + (size_t)row * 1024 + col0 + bj * HALF) = pack8(v0, v1); }
                ss += __shfl_xor(ss, 16); ss += __shfl_xor(ss, 32);
                if (fq == 0) sse[(size_t)row * 16 + u.pn * 4 + wc] = ss; }
    }
};
struct EpiRes {
    static constexpr bool PERM = true, AFTER_DRAIN = true;
    const float* base; float* out; bf16_t* hb; float* ss;
    __device__ __forceinline__ void fused(f32x4 (&acc)[2][2][4][2], const Unit& u, int wr, int wc, int fr, int fq, PG8_LAS unsigned char* lds, int wid, int lane) const {
        PG8_LAS float* P = (PG8_LAS float*)lds;
        const int col0 = u.pn * BM + wc * 32 + 8 * fq;
#pragma unroll
        for (int ai = 0; ai < 2; ++ai)
#pragma unroll
            for (int m = 0; m < 4; ++m) { const int rl = ai * HALF + wr * 64 + m * 16 + fr; float s = 0.f;
#pragma unroll
                for (int bj = 0; bj < 2; ++bj) { const size_t off = (size_t)(u.pm * BM + rl) * 1024 + col0 + bj * HALF;
                    const f32x4 h0 = *(const f32x4*)(base + off) + acc[ai][bj][m][0], h1 = *(const f32x4*)(base + off + 4) + acc[ai][bj][m][1];
                    *(f32x4*)(out + off) = h0; *(f32x4*)(out + off + 4) = h1; *(u32x4*)(hb + off) = pack8(h0, h1); s += dot4(h0, h0) + dot4(h1, h1); }
                s += __shfl_xor(s, 16); s += __shfl_xor(s, 32);
                if (fq == 0) P[rl * 4 + wc] = s; }
        asm volatile("s_waitcnt lgkmcnt(0)" ::: "memory"); __builtin_amdgcn_s_barrier(); asm volatile("" ::: "memory");
        const int t = wid * 64 + lane;
        if (t < 256) { const f32x4 p = *(const PG8_LAS f32x4*)(P + t * 4); ss[(size_t)(u.pm * BM + t) * 4 + u.pn] = (p[0] + p[1]) + (p[2] + p[3]); }
    }
};
struct EpiUp {
    static constexpr bool PERM = true, AFTER_DRAIN = false;
    bf16_t* HB; const PG8_LAS float* rs;
    __device__ __forceinline__ void operator()(const f32x4 (&acc)[2][2][4][2], const Unit& u, int wr, int wc, int fr, int fq) const {
        const int col0 = u.pn * BM + wc * 32 + 8 * fq;
#pragma unroll
        for (int ai = 0; ai < 2; ++ai)
#pragma unroll
            for (int m = 0; m < 4; ++m) { const int rl = ai * HALF + wr * 64 + m * 16 + fr; const float r = rs[rl]; bf16_t* rowp = HB + (size_t)(u.pm * BM + rl) * 4096 + col0;
#pragma unroll
                for (int bj = 0; bj < 2; ++bj) { f32x4 v0 = acc[ai][bj][m][0] * r, v1 = acc[ai][bj][m][1] * r;
#pragma unroll
                    for (int e = 0; e < 4; ++e) { const float a = fmaxf(v0[e], 0.f), b = fmaxf(v1[e], 0.f); v0[e] = a * a; v1[e] = b * b; }
                    *(u32x4*)(rowp + bj * HALF) = pack8(v0, v1); } }
    }
};
struct EpiPle {
    static constexpr bool PERM = true, AFTER_DRAIN = false;
    float* y; const bf16_t* ER; const float* pn; const PG8_LAS float* rs3; const PG8_LAS float* rse;
    __device__ __forceinline__ void operator()(const f32x4 (&acc)[2][2][4][2], const Unit& u, int wr, int wc, int fr, int fq) const {
        const int col0 = u.pn * BM + wc * 32 + 8 * fq;
        f32x4 gn[2][2];
#pragma unroll
        for (int bj = 0; bj < 2; ++bj)
#pragma unroll
            for (int n = 0; n < 2; ++n) gn[bj][n] = *(const f32x4*)(pn + col0 + bj * HALF + 4 * n);
#pragma unroll
        for (int ai = 0; ai < 2; ++ai)
#pragma unroll
            for (int m = 0; m < 4; ++m) { const int rl = ai * HALF + wr * 64 + m * 16 + fr; const float r3 = rs3[rl], re = rse[rl];
#pragma unroll
                for (int bj = 0; bj < 2; ++bj) { const size_t off = (size_t)(u.pm * BM + rl) * 1024 + col0 + bj * HALF;
                    const u32x4 ew = *(const u32x4*)(ER + off); const f32x4 e0 = bf4_to_f32((u32x2){ew.x, ew.y}), e1 = bf4_to_f32((u32x2){ew.z, ew.w});
                    f32x4 y0 = *(const f32x4*)(y + off), y1 = *(const f32x4*)(y + off + 4);
#pragma unroll
                    for (int e = 0; e < 4; ++e) { const float g0 = __builtin_amdgcn_rcpf(1.0f + __builtin_amdgcn_exp2f(-1.4426950408889634f * r3 * acc[ai][bj][m][0][e]));
                        const float g1 = __builtin_amdgcn_rcpf(1.0f + __builtin_amdgcn_exp2f(-1.4426950408889634f * r3 * acc[ai][bj][m][1][e]));
                        y0[e] += g0 * (e0[e] * re * gn[bj][0][e]); y1[e] += g1 * (e1[e] * re * gn[bj][1][e]); }
                    *(f32x4*)(y + off) = y0; *(f32x4*)(y + off + 4) = y1; } }
    }
};
template <class Epi, class Sched, bool ALIGN_EPI = false, bool SP2 = false>
__device__ __forceinline__ void gemm_phase(PG8_LAS unsigned char* lds, const Gemm g, const Sched& S, const Epi& E) {
    const int tid = threadIdx.x, wid = __builtin_amdgcn_readfirstlane(tid >> 6), lane = tid & 63, wr = wid >> 2, wc = wid & 3, fr = lane & 15, fq = lane >> 4;
    const int K = g.K, nt = K / BK;
    unsigned voffA[2], voffB[2];
#pragma unroll
    for (int i = 0; i < 2; ++i) { int R, C; stage_rc(tid * 16 + i * 8192, R, C); const int Rb = Epi::PERM ? ((R & ~31) + perm32(R & 31)) : R;
        voffA[i] = (unsigned)(R * K + C) * 2u; voffB[i] = (unsigned)(Rb * K + C) * 2u; }
    const size_t kstep = (size_t)(BK * 2);
    const size_t hstep = (size_t)HALF * K * 2;
    const size_t tstep = 2 * hstep;
    const unsigned ldsw = (unsigned)wid * 1024u;
    const int aoff = lds_byte(wr * 64 + fr, fq * 8), boff = lds_byte(wc * 32 + fr, fq * 8);
#define PG8_SA(b, h) (((b) * 2 + (h)) * HTB)
#define PG8_SB(b, h) ((4 + (b) * 2 + (h)) * HTB)
#define PG8_STAGE(bufoff, gbase, voff) do { _Pragma("unroll") for (int _i = 0; _i < 2; ++_i) \
        __builtin_amdgcn_global_load_lds((const unsigned*)((const char*)(gbase) + (voff)[_i]), (PG8_LAS unsigned*)(lds + (bufoff) + ldsw + _i * 8192), 16, 0, 0); } while (0)
#define PG8_LDA(dst, b, h) do { _Pragma("unroll") for (int m = 0; m < 4; ++m) _Pragma("unroll") for (int k = 0; k < 2; ++k) dst[m][k] = *(const PG8_LAS bf16x8*)(lds + PG8_SA(b, h) + aoff + m * 2048 + k * 1024); } while (0)
#define PG8_LDB(dst, b, h) do { _Pragma("unroll") for (int n = 0; n < 2; ++n) _Pragma("unroll") for (int k = 0; k < 2; ++k) dst[n][k] = *(const PG8_LAS bf16x8*)(lds + PG8_SB(b, h) + boff + n * 2048 + k * 1024); } while (0)
#define PG8_MMA(ai, bj, At, Bt) do { __builtin_amdgcn_s_setprio(1); _Pragma("unroll") for (int m = 0; m < 4; ++m) _Pragma("unroll") for (int n = 0; n < 2; ++n) _Pragma("unroll") for (int k = 0; k < 2; ++k) \
        acc[ai][bj][m][n] = __builtin_amdgcn_mfma_f32_16x16x32_bf16(Bt[n][k], At[m][k], acc[ai][bj][m][n], 0, 0, 0); __builtin_amdgcn_s_setprio(0); } while (0)
#define PG8_WAIT_V(n) asm volatile("s_waitcnt vmcnt(" #n ")" ::: "memory")
#define PG8_WAIT_L(n) asm volatile("s_waitcnt lgkmcnt(" #n ")" ::: "memory")
#define PG8_BAR __builtin_amdgcn_s_barrier()
#define PG8_SCHED __builtin_amdgcn_sched_barrier(0)
    Unit cur, nxt; int ui = 0;
    if (!S.next(0, cur)) return;
    f32x4 acc[2][2][4][2];
#pragma unroll
    for (int a = 0; a < 2; ++a)
#pragma unroll
        for (int b = 0; b < 2; ++b)
#pragma unroll
            for (int m = 0; m < 4; ++m)
#pragma unroll
                for (int n = 0; n < 2; ++n) acc[a][b][m][n] = (f32x4){0.f, 0.f, 0.f, 0.f};
    bf16x8 At[4][2], B0[2][2], B1[2][2];
    const char* cA = (const char*)g.A + (size_t)cur.pm * tstep; const char* cB = (const char*)g.Bt + (size_t)cur.pn * tstep;
    S.a_ready(cur);
    if constexpr (SP2) {
        PG8_STAGE(PG8_SB(0, 0), cB, voffB); PG8_STAGE(PG8_SB(0, 1), cB + hstep, voffB); PG8_STAGE(PG8_SA(0, 0), cA, voffA); PG8_STAGE(PG8_SA(0, 1), cA + hstep, voffA);
        if (wr == 1) PG8_BAR;
        PG8_WAIT_V(2); PG8_BAR;
        PG8_STAGE(PG8_SB(1, 0), cB + kstep, voffB); PG8_STAGE(PG8_SA(1, 0), cA + kstep, voffA); PG8_STAGE(PG8_SB(1, 1), cB + hstep + kstep, voffB);
        PG8_WAIT_V(6); PG8_BAR;
    } else {
        PG8_STAGE(PG8_SB(0, 0), cB, voffB); PG8_STAGE(PG8_SA(0, 0), cA, voffA); PG8_STAGE(PG8_SB(0, 1), cB + hstep, voffB); PG8_STAGE(PG8_SA(0, 1), cA + hstep, voffA);
        if (wr == 1) PG8_BAR;
        PG8_WAIT_V(4); PG8_BAR;
        PG8_STAGE(PG8_SB(1, 0), cB + kstep, voffB); PG8_STAGE(PG8_SA(1, 0), cA + kstep, voffA); PG8_STAGE(PG8_SB(1, 1), cB + hstep + kstep, voffB);
        PG8_WAIT_V(6); PG8_BAR;
    }
    for (;;) {
        const bool has_next = S.next(ui + 1, nxt);
        const char* nA = has_next ? (const char*)g.A + (size_t)nxt.pm * tstep : cA; const char* nB = has_next ? (const char*)g.Bt + (size_t)nxt.pn * tstep : cB;
        for (int t = 0; t < nt; t += 2) {
            const bool last = (t == nt - 2);
            const char* a1 = cA + (size_t)(t + 1) * kstep;
            const char* a2 = last ? nA : cA + (size_t)(t + 2) * kstep; const char* b2 = last ? nB : cB + (size_t)(t + 2) * kstep;
            const char* a3 = a2 + kstep; const char* b3 = b2 + kstep;
            if (last && has_next) S.a_ready(nxt);
            if constexpr (SP2) {
            PG8_LDB(B0, 0, 0); PG8_LDB(B1, 0, 1); PG8_SCHED; PG8_LDA(At, 0, 0); PG8_STAGE(PG8_SA(1, 1), a1 + hstep, voffA);
            PG8_WAIT_V(8); PG8_WAIT_L(0); PG8_BAR; PG8_MMA(0, 0, At, B0); PG8_MMA(0, 1, At, B1); PG8_BAR; PG8_SCHED;
            PG8_LDA(At, 0, 1); PG8_STAGE(PG8_SB(0, 0), b2, voffB); PG8_STAGE(PG8_SB(0, 1), b2 + hstep, voffB); PG8_STAGE(PG8_SA(0, 0), a2, voffA);
            PG8_WAIT_V(8); PG8_WAIT_L(0); PG8_BAR; PG8_MMA(1, 0, At, B0); PG8_MMA(1, 1, At, B1); PG8_BAR; PG8_SCHED;
            PG8_LDB(B0, 1, 0); PG8_LDB(B1, 1, 1); PG8_SCHED; PG8_LDA(At, 1, 0); PG8_STAGE(PG8_SA(0, 1), a2 + hstep, voffA);
            PG8_WAIT_V(8); PG8_WAIT_L(0); PG8_BAR; PG8_MMA(0, 0, At, B0); PG8_MMA(0, 1, At, B1); PG8_BAR; PG8_SCHED;
            PG8_LDA(At, 1, 1); PG8_STAGE(PG8_SB(1, 0), b3, voffB); PG8_STAGE(PG8_SB(1, 1), b3 + hstep, voffB); PG8_STAGE(PG8_SA(1, 0), a3, voffA);
            PG8_WAIT_V(8); PG8_WAIT_L(0); PG8_BAR; PG8_MMA(1, 0, At, B0); PG8_MMA(1, 1, At, B1); PG8_BAR; PG8_SCHED;
            } else {
            PG8_LDB(B0, 0, 0); PG8_SCHED; PG8_LDA(At, 0, 0); PG8_STAGE(PG8_SA(1, 1), a1 + hstep, voffA);
            PG8_WAIT_L(8); PG8_BAR; PG8_WAIT_L(0); PG8_MMA(0, 0, At, B0); PG8_BAR; PG8_SCHED;
            PG8_LDB(B1, 0, 1); PG8_STAGE(PG8_SB(0, 0), b2, voffB);
            PG8_BAR; PG8_WAIT_L(0); PG8_MMA(0, 1, At, B1); PG8_BAR;
            PG8_LDA(At, 0, 1); PG8_STAGE(PG8_SA(0, 0), a2, voffA);
            PG8_BAR; PG8_WAIT_L(0); PG8_MMA(1, 0, At, B0); PG8_BAR; PG8_SCHED;
            PG8_STAGE(PG8_SB(0, 1), b2 + hstep, voffB);
            PG8_WAIT_V(6); PG8_BAR; PG8_MMA(1, 1, At, B1); PG8_BAR;
            PG8_LDB(B0, 1, 0); PG8_SCHED; PG8_LDA(At, 1, 0); PG8_STAGE(PG8_SA(0, 1), a2 + hstep, voffA);
            PG8_WAIT_L(8); PG8_BAR; PG8_WAIT_L(0); PG8_MMA(0, 0, At, B0); PG8_BAR; PG8_SCHED;
            PG8_LDB(B1, 1, 1); PG8_STAGE(PG8_SB(1, 0), b3, voffB);
            PG8_BAR; PG8_WAIT_L(0); PG8_MMA(0, 1, At, B1); PG8_BAR;
            PG8_LDA(At, 1, 1); PG8_STAGE(PG8_SA(1, 0), a3, voffA);
            PG8_BAR; PG8_WAIT_L(0); PG8_MMA(1, 0, At, B0); PG8_BAR; PG8_SCHED;
            PG8_STAGE(PG8_SB(1, 1), b3 + hstep, voffB);
            PG8_WAIT_V(6); PG8_BAR; PG8_MMA(1, 1, At, B1); PG8_BAR;
            }
        }
        if constexpr (ALIGN_EPI) { if (wr == 0) PG8_BAR; }
        if constexpr (!Epi::AFTER_DRAIN) { E(acc, cur, wr, wc, fr, fq); S.done(cur); }
        if (!has_next) break;
#pragma unroll
        for (int a = 0; a < 2; ++a)
#pragma unroll
            for (int b = 0; b < 2; ++b)
#pragma unroll
                for (int m = 0; m < 4; ++m)
#pragma unroll
                    for (int n = 0; n < 2; ++n) acc[a][b][m][n] = (f32x4){0.f, 0.f, 0.f, 0.f};
        cur = nxt; cA = nA; cB = nB; ++ui;
        if constexpr (ALIGN_EPI) { if (wr == 1) PG8_BAR; }
    }
    PG8_WAIT_V(0);
    if constexpr (!ALIGN_EPI) { if (wr == 0) PG8_BAR; }
    PG8_BAR;
    if constexpr (Epi::AFTER_DRAIN) { E.fused(acc, cur, wr, wc, fr, fq, lds, wid, lane); S.done(cur); }
#undef PG8_SA
#undef PG8_SB
#undef PG8_STAGE
#undef PG8_LDA
#undef PG8_LDB
#undef PG8_MMA
#undef PG8_WAIT_V
#undef PG8_WAIT_L
#undef PG8_BAR
#undef PG8_SCHED
}
}
#ifndef PG8_SP2
#define PG8_SP2 true
#endif
#define GAS __attribute__((address_space(1)))
#define LAS __attribute__((address_space(3)))
typedef unsigned short bf16;
typedef unsigned v4u __attribute__((ext_vector_type(4)));
typedef float f32x4 __attribute__((ext_vector_type(4)));
typedef short bf16x8 __attribute__((ext_vector_type(8)));
typedef GAS unsigned gu32;
typedef GAS unsigned long long gu64;
#define RLX_AGENT __ATOMIC_RELAXED, __HIP_MEMORY_SCOPE_AGENT
#define LDS_WAIT() asm volatile("s_waitcnt lgkmcnt(0)" ::: "memory")
#define VM_WAIT() asm volatile("s_waitcnt vmcnt(0)" ::: "memory")
__device__ __forceinline__ unsigned long long rt() { return __builtin_amdgcn_s_memrealtime(); }
__device__ __forceinline__ unsigned f2bf(float f) { unsigned u = __builtin_bit_cast(unsigned, f); return (u + 0x7fffu + ((u >> 16) & 1u)) >> 16; }
__device__ __forceinline__ unsigned pk2(float lo, float hi) { return f2bf(lo) | (f2bf(hi) << 16); }

#define XB_TMO      128
#define XB_XCNT(j)  (256  + 64 * (j))
#define XB_XSUB(j)  (1280 + 64 * (j))
#define XB_XGEN(j)  (2304 + 64 * (j))
#define XB_TOP      3328
#define XB_TOPGEN   3392
#define XCD_BAR_WORDS 3456
#define XB_SPIN_CAP (1u << 18)

__device__ __forceinline__ unsigned xb_ld(unsigned* p)              { return __hip_atomic_load(p, __ATOMIC_RELAXED, __HIP_MEMORY_SCOPE_AGENT); }
__device__ __forceinline__ unsigned xb_add(unsigned* p, unsigned v) { return __hip_atomic_fetch_add(p, v, __ATOMIC_RELAXED, __HIP_MEMORY_SCOPE_AGENT); }
__device__ __forceinline__ unsigned xb_xcc_id() { return (unsigned)__builtin_amdgcn_s_getreg((3 << 11) | 20) & 0xFu; }
#define XB_SPIN(cond, bar) do { unsigned _sp = 0; while (cond) { __builtin_amdgcn_s_sleep(1); \
    if ((++_sp & 255u) == 0u) { if (xb_ld(&(bar)[XB_TMO])) break; if (_sp > XB_SPIN_CAP) { atomicAdd(&(bar)[XB_TMO], 1u); break; } } } } while (0)

struct XcdBarrier {
    unsigned* bar; unsigned x;
    volatile LAS unsigned* st;
};

__device__ __forceinline__ XcdBarrier xcd_barrier_post(unsigned* bar, volatile LAS unsigned* st) {
    XcdBarrier b; b.bar = bar; b.x = xb_xcc_id(); b.st = st;
    if (threadIdx.x == 0) (void)xb_add(&bar[XB_XCNT(b.x)], 1u);
    return b;
}
__device__ __forceinline__ void xcd_barrier_complete(unsigned* bar, unsigned x, unsigned& nloc, unsigned& nx) {
    const unsigned G = gridDim.x * gridDim.y * gridDim.z;
    unsigned sum, cnt, mine, sp = 0u;
    for (;;) {
        sum = 0u; cnt = 0u; mine = 0u;
#pragma unroll
        for (unsigned j = 0; j < 16; ++j) { const unsigned c = xb_ld(&bar[XB_XCNT(j)]); sum += c; cnt += (c > 0u) ? 1u : 0u; mine = (j == x) ? c : mine; }
        if (sum == G) break;
        __builtin_amdgcn_s_sleep(1);
        if ((++sp & 255u) == 0u) { if (xb_ld(&bar[XB_TMO])) break; if (sp > XB_SPIN_CAP) { atomicAdd(&bar[XB_TMO], 1u); break; } }
    }
    nloc = mine > 0u ? mine : 1u; nx = cnt > 0u ? cnt : 1u;
}

__device__ __forceinline__ void xcd_barrier(const XcdBarrier& b) {
    asm volatile("s_waitcnt vmcnt(0)" ::: "memory");
    __syncthreads();
    if (threadIdx.x == 0) {
        unsigned* bar = b.bar;
        __builtin_amdgcn_s_waitcnt(0);
        unsigned nloc = b.st[0], nx = b.st[1];
        if (nloc == 0u) { xcd_barrier_complete(bar, b.x, nloc, nx); b.st[0] = nloc; b.st[1] = nx; }
        const unsigned old = xb_add(&bar[XB_XSUB(b.x)], 1u);
        const unsigned gen = old / nloc;
        if (old + 1u == (gen + 1u) * nloc) {
            __builtin_amdgcn_fence(__ATOMIC_RELEASE, "agent");
            asm volatile("s_waitcnt vmcnt(0)" ::: "memory");
            const unsigned og = xb_add(&bar[XB_TOP], 1u);
            const unsigned tg = og / nx;
            if (og + 1u == (tg + 1u) * nx) xb_add(&bar[XB_TOPGEN], 1u);
            else XB_SPIN(xb_ld(&bar[XB_TOPGEN]) == tg, bar);
            __builtin_amdgcn_fence(__ATOMIC_ACQUIRE, "agent");
            xb_add(&bar[XB_XGEN(b.x)], 1u);
            asm volatile("s_waitcnt vmcnt(0)" ::: "memory");
        } else {
            XB_SPIN(xb_ld(&bar[XB_XGEN(b.x)]) == gen, bar);
            __builtin_amdgcn_fence(__ATOMIC_ACQUIRE, "agent");
            asm volatile("s_waitcnt vmcnt(0)" ::: "memory");
        }
    }
    __syncthreads();
}
typedef unsigned u32x2 __attribute__((ext_vector_type(2)));
constexpr int DM = 1024, SEQ = 2048, NBAT = 8, MP = NBAT * SEQ;
constexpr int MS = 128, DBAT = 32, DSEQ = 4, NPAGES = 64;
constexpr int NIN = 2560, FF = 4096, DPLE = 256;
constexpr float EPS = 1e-6f;
constexpr float C2 = 0.125f * 1.4426950408889634f;
constexpr size_t O_YP = 0, O_YS = 16777216, O_KP = 16908288, O_VP = 25296896, O_KS = 33685504, O_VS = 33751040, O_AV = 33816576, O_END = 33882112;
constexpr size_t MiB = 1u << 20;
constexpr size_t WS_CTL = 0, CTL_ZERO_BYTES = 1 * MiB;
constexpr size_t WS_WIN = 2 * MiB, WS_WOUT = 8 * MiB, WS_WUP = 10 * MiB, WS_WDN = 18 * MiB, WS_WPG = 26 * MiB, WS_WPP = 28 * MiB, WS_WTRIL = 29 * MiB;
constexpr size_t WS_KMP = 30 * MiB, WS_KMS = 31 * MiB, WS_SS2 = 34 * MiB, WS_SS3 = 35 * MiB, WS_SSE = 36 * MiB;
constexpr size_t WS_XNS = 40 * MiB, WS_PBS = 41 * MiB, WS_US = 42 * MiB, WS_VAS = 43 * MiB, WS_QS = 44 * MiB, WS_MIXS = 45 * MiB, WS_H1BS = 46 * MiB, WS_HBS = 47 * MiB, WS_H2BS = 48 * MiB, WS_ERS = 49 * MiB,
                 WS_SS2S = 50 * MiB, WS_SS3S = 51 * MiB;
constexpr size_t WS_XN = 64 * MiB, WS_PB = 96 * MiB, WS_U = 104 * MiB, WS_VA = 120 * MiB, WS_Q = 136 * MiB, WS_K = 152 * MiB, WS_V = 168 * MiB, WS_MIX = 184 * MiB, WS_H1B = 216 * MiB, WS_H2B = 248 * MiB,
                 WS_ER = 280 * MiB, WS_HB = 312 * MiB, WS_END = 440 * MiB;
constexpr int CW_BAR = 4096;
constexpr int SCR_BYTES = 139264;
constexpr int RS0_OFF = SCR_BYTES, RS1_OFF = RS0_OFF + 1024, MISC_OFF = RS1_OFF + 1024;
constexpr int LDS_BYTES = 147456;
constexpr int NWAVES = 8, NTHR = 512;
static_assert(MISC_OFF + 256 <= LDS_BYTES, "LDS map");

struct Args { const float* in[22]; float* out; unsigned char* ws; int ph_lo, ph_hi; };
enum { I_XP = 0, I_XS, I_PP, I_PS, I_CK, I_CV, I_PT, I_LN1, I_WIN, I_AVN, I_AWS, I_ABS, I_QN, I_KN, I_WOUT, I_LN2, I_WUP, I_WDN, I_LN3, I_WPG, I_WPP, I_PLN };

__device__ __forceinline__ int perm_in(int L) { return (L & ~255) | (((L >> 5) & 1) << 7) | (((L >> 6) & 3) << 5) | (L & 31); }
__device__ __forceinline__ float wave_sum(float v) {
#pragma unroll
    for (int o = 1; o < 64; o <<= 1) v += __shfl_xor(v, o);
    return v;
}
__device__ __forceinline__ float wave_max(float v) {
#pragma unroll
    for (int o = 1; o < 64; o <<= 1) v = fmaxf(v, __shfl_xor(v, o));
    return v;
}
__device__ __forceinline__ float bfu(unsigned short h) { return __uint_as_float((unsigned)h << 16); }

__device__ __forceinline__ void transpose_item(const float* W, int K, int N, bf16* WT, int out_row0, const float* kscale, LAS float* scr, int k0, int n0, int lane) {
#pragma unroll 8
    for (int i = 0; i < 32; ++i) { const int kk = 2 * i + (lane >> 5); float v = W[(size_t)(k0 + kk) * N + n0 + (lane & 31)]; if (kscale) v *= kscale[k0 + kk]; scr[kk * 33 + (lane & 31)] = v; }
    LDS_WAIT(); asm volatile("" ::: "memory");
    const int c = lane & 7;
#pragma unroll
    for (int j = 0; j < 4; ++j) { const int n = (lane >> 3) + 8 * j; const LAS float* s = scr + (8 * c) * 33 + n;
        v4u o; o.x = pk2(s[0 * 33], s[1 * 33]); o.y = pk2(s[2 * 33], s[3 * 33]); o.z = pk2(s[4 * 33], s[5 * 33]); o.w = pk2(s[6 * 33], s[7 * 33]);
        *(v4u*)(WT + (size_t)(out_row0 + n) * K + k0 + 8 * c) = o; }
    LDS_WAIT(); asm volatile("" ::: "memory");
}
__device__ __forceinline__ void rms_row_to_bf16(const float* xrow, const float* gain, bf16* orow, int lane) {
    const f32x4* xr = (const f32x4*)xrow + lane; const f32x4* gr = (const f32x4*)gain + lane;
    f32x4 v[4]; float s = 0.f;
#pragma unroll
    for (int j = 0; j < 4; ++j) { v[j] = xr[64 * j]; s += (v[j].x * v[j].x + v[j].y * v[j].y) + (v[j].z * v[j].z + v[j].w * v[j].w); }
    const float rstd = 1.0f / sqrtf(wave_sum(s) * (1.0f / 1024.0f) + EPS);
    unsigned long long* o8 = (unsigned long long*)orow + lane;
#pragma unroll
    for (int j = 0; j < 4; ++j) { const f32x4 g = gr[64 * j]; o8[64 * j] = (unsigned long long)pk2(v[j].x * rstd * g.x, v[j].y * rstd * g.y) | ((unsigned long long)pk2(v[j].z * rstd * g.z, v[j].w * rstd * g.w) << 32); }
}

template <bool PERMUTED, class Epi>
__device__ __forceinline__ void thin_unit(LAS unsigned char* lds, const bf16* A, int lda, const bf16* Bt, int ldb, int K, int rh, int ct, const Epi& epi) {
    const int tid = threadIdx.x, lane = tid & 63, w = __builtin_amdgcn_readfirstlane(tid >> 6), fr = lane & 15, fq = lane >> 4;
    const int ks = K >> 3, kbeg = w * ks;
    f32x4 acc[4][4];
#pragma unroll
    for (int nt = 0; nt < 4; ++nt)
#pragma unroll
        for (int mt = 0; mt < 4; ++mt) acc[nt][mt] = (f32x4){0.f, 0.f, 0.f, 0.f};
    const bf16* ap = A + (size_t)(rh * 64 + fr) * lda + kbeg + 8 * fq;
    const bf16* bp[4];
#pragma unroll
    for (int nt = 0; nt < 4; ++nt) { const int L = 64 * ct + 16 * nt; const int p = PERMUTED ? perm_in(L) : L; bp[nt] = Bt + (size_t)(p + fr) * ldb + kbeg + 8 * fq; }
#pragma unroll 2
    for (int k = 0; k < ks; k += 32) {
        bf16x8 a[4], b[4];
#pragma unroll
        for (int mt = 0; mt < 4; ++mt) a[mt] = *(const bf16x8*)(ap + (size_t)mt * 16 * lda + k);
#pragma unroll
        for (int nt = 0; nt < 4; ++nt) b[nt] = *(const bf16x8*)(bp[nt] + k);
#pragma unroll
        for (int nt = 0; nt < 4; ++nt)
#pragma unroll
            for (int mt = 0; mt < 4; ++mt) acc[nt][mt] = __builtin_amdgcn_mfma_f32_16x16x32_bf16(b[nt], a[mt], acc[nt][mt], 0, 0, 0);
    }
    LAS float* red = (LAS float*)lds;
#pragma unroll
    for (int nt = 0; nt < 4; ++nt)
#pragma unroll
        for (int mt = 0; mt < 4; ++mt) *(LAS f32x4*)(red + w * (64 * 68) + (16 * mt + fr) * 68 + 16 * nt + 4 * fq) = acc[nt][mt];
    __syncthreads();
    const int row = tid >> 3, cg = tid & 7;
    float v[8];
#pragma unroll
    for (int e = 0; e < 8; ++e) v[e] = 0.f;
#pragma unroll
    for (int ww = 0; ww < 8; ++ww) { const f32x4 x0 = *(const LAS f32x4*)(red + ww * (64 * 68) + row * 68 + 8 * cg), x1 = *(const LAS f32x4*)(red + ww * (64 * 68) + row * 68 + 8 * cg + 4);
#pragma unroll
        for (int e = 0; e < 4; ++e) { v[e] += x0[e]; v[4 + e] += x1[e]; } }
    epi(rh * 64 + row, ct, cg, v);
    __syncthreads();
}
__device__ __forceinline__ void st_bf8(bf16* p, const float (&v)[8]) { v4u o; o.x = pk2(v[0], v[1]); o.y = pk2(v[2], v[3]); o.z = pk2(v[4], v[5]); o.w = pk2(v[6], v[7]); *(v4u*)p = o; }
__device__ __forceinline__ void st_f8(float* p, const float (&v)[8]) { *(f32x4*)p = (f32x4){v[0], v[1], v[2], v[3]}; *(f32x4*)(p + 4) = (f32x4){v[4], v[5], v[6], v[7]}; }
__device__ __forceinline__ float sum8sq(const float (&v)[8]) { float s = 0.f;
#pragma unroll
    for (int e = 0; e < 8; ++e) s += v[e] * v[e]; return s; }
__device__ __forceinline__ float red8(float s) { s += __shfl_xor(s, 1); s += __shfl_xor(s, 2); s += __shfl_xor(s, 4); return s; }

__device__ __forceinline__ void gate_prompt_unit(LAS unsigned char* lds, const bf16* VA, const bf16* U, const bf16* WTRIL, const float* avn, const float* abs_, bf16* MIX, int b, int c, int g) {
    const int tid = threadIdx.x, lane = tid & 63, wv = __builtin_amdgcn_readfirstlane(tid >> 6), fr = lane & 15, fq = lane >> 4;
    const size_t tok0 = (size_t)b * SEQ + (size_t)c * 128;
    LAS bf16* VT = (LAS bf16*)lds;
    { const int r = tid >> 2, qd = tid & 3; const bf16* src = VA + (tok0 + r) * 512 + g * 128 + 32 * qd;
      v4u x[4]; float ss = 0.f;
#pragma unroll
      for (int i = 0; i < 4; ++i) x[i] = *(const v4u*)(src + 8 * i);
      float f[32];
#pragma unroll
      for (int i = 0; i < 4; ++i) { f[8 * i + 0] = __uint_as_float(x[i].x << 16); f[8 * i + 1] = __uint_as_float(x[i].x & 0xffff0000u); f[8 * i + 2] = __uint_as_float(x[i].y << 16); f[8 * i + 3] = __uint_as_float(x[i].y & 0xffff0000u);
          f[8 * i + 4] = __uint_as_float(x[i].z << 16); f[8 * i + 5] = __uint_as_float(x[i].z & 0xffff0000u); f[8 * i + 6] = __uint_as_float(x[i].w << 16); f[8 * i + 7] = __uint_as_float(x[i].w & 0xffff0000u); }
#pragma unroll
      for (int i = 0; i < 32; ++i) ss += f[i] * f[i];
      ss += __shfl_xor(ss, 1); ss += __shfl_xor(ss, 2);
      const float rstd = 1.0f / sqrtf(ss * (1.0f / 128.0f) + EPS);
#pragma unroll
      for (int i = 0; i < 32; ++i) { const int w = 32 * qd + i; VT[w * 136 + r] = (bf16)f2bf(f[i] * rstd * avn[g * 128 + w]); }
    }
    __syncthreads();
    f32x4 acc[8];
#pragma unroll
    for (int wt = 0; wt < 8; ++wt) acc[wt] = (f32x4){0.f, 0.f, 0.f, 0.f};
#pragma unroll
    for (int ks = 0; ks < 4; ++ks) {
        if (32 * ks <= 16 * wv + 15) {
            const bf16x8 bw = *(const bf16x8*)(WTRIL + ((size_t)g * 128 + 16 * wv + fr) * 128 + 32 * ks + 8 * fq);
#pragma unroll
            for (int wt = 0; wt < 8; ++wt) { const bf16x8 av = *(const LAS bf16x8*)(VT + (16 * wt + fr) * 136 + 32 * ks + 8 * fq);
                acc[wt] = __builtin_amdgcn_mfma_f32_16x16x32_bf16(av, bw, acc[wt], 0, 0, 0); }
        }
    }
    { const int t = 16 * wv + fr; const size_t tok = tok0 + t; const float bias = abs_[g * 128 + t];
#pragma unroll
      for (int wt = 0; wt < 8; ++wt) { const int w0 = 16 * wt + 4 * fq; const u32x2 uw = *(const u32x2*)(U + tok * 512 + g * 128 + w0); const f32x4 uf = pg8::bf4_to_f32(uw);
          u32x2 o; o.x = pk2(uf[0] * (acc[wt][0] + bias), uf[1] * (acc[wt][1] + bias)); o.y = pk2(uf[2] * (acc[wt][2] + bias), uf[3] * (acc[wt][3] + bias));
          *(u32x2*)(MIX + tok * 1024 + g * 128 + w0) = o; } }
    __syncthreads();
}
__device__ __forceinline__ void gate_sample_unit(LAS unsigned char* lds, const float* VAS, const float* US, const float* aws, const float* avn, const float* abs_, bf16* MIXS, float* av_out, int b) {
    const int tid = threadIdx.x, lane = tid & 63, wv = tid >> 6, g = tid >> 7;
    LAS float* red = (LAS float*)lds;
    float v[4], ss[4];
#pragma unroll
    for (int s = 0; s < 4; ++s) { v[s] = VAS[(size_t)(4 * b + s) * 512 + tid]; ss[s] = wave_sum(v[s] * v[s]); }
    if (lane == 0) {
#pragma unroll
        for (int s = 0; s < 4; ++s) red[wv * 4 + s] = ss[s]; }
    __syncthreads();
    const float gain = avn[tid];
#pragma unroll
    for (int s = 0; s < 4; ++s) { const float tot = red[(2 * g) * 4 + s] + red[(2 * g + 1) * 4 + s]; v[s] = v[s] * (1.0f / sqrtf(tot * (1.0f / 128.0f) + EPS)) * gain; av_out[(size_t)(4 * b + s) * 512 + tid] = v[s]; }
#pragma unroll
    for (int t = 0; t < 4; ++t) { float sg = abs_[g * 128 + t];
#pragma unroll
        for (int s = 0; s < 4; ++s) if (s <= t) sg += aws[((size_t)g * 128 + t) * 128 + s] * v[s];
        MIXS[(size_t)(4 * b + t) * 1024 + tid] = (bf16)f2bf(US[(size_t)(4 * b + t) * 512 + tid] * sg); }
    __syncthreads();
}
__device__ __forceinline__ void moba_prompt_simple(LAS unsigned char* lds, const bf16* Q, const bf16* K, const bf16* V, const float* KMP, bf16* MIX, int b, int hp, int qb) {
    const int tid = threadIdx.x, hl = tid >> 8, qi = tid & 255, h = 2 * hp + hl;
    const size_t row = (size_t)b * SEQ + (size_t)qb * 256 + qi;
    LAS float* km = (LAS float*)lds;
    LAS bf16* kt = (LAS bf16*)(lds + 4096);
    LAS bf16* vt = (LAS bf16*)(lds + 4096 + 16384);
    float q[64];
    { const v4u* qp = (const v4u*)(Q + row * 512 + h * 64);
#pragma unroll
      for (int i = 0; i < 8; ++i) { const v4u x = qp[i]; q[8 * i + 0] = __uint_as_float(x.x << 16); q[8 * i + 1] = __uint_as_float(x.x & 0xffff0000u); q[8 * i + 2] = __uint_as_float(x.y << 16); q[8 * i + 3] = __uint_as_float(x.y & 0xffff0000u);
          q[8 * i + 4] = __uint_as_float(x.z << 16); q[8 * i + 5] = __uint_as_float(x.z & 0xffff0000u); q[8 * i + 6] = __uint_as_float(x.w << 16); q[8 * i + 7] = __uint_as_float(x.w & 0xffff0000u); } }
    for (int idx = tid; idx < 1024; idx += NTHR) { const int hh = idx >> 9, j = (idx >> 6) & 7, d = idx & 63; float val = 0.f;
        if (j < qb) { const int pm = b * 8 + j, col = (2 * hp + hh) * 64 + d; val = (KMP[(size_t)(pm * 2) * 512 + col] + KMP[(size_t)(pm * 2 + 1) * 512 + col]) * (1.0f / 256.0f); }
        km[idx] = val; }
    __syncthreads();
    unsigned sel = 0;
    { float gsc[8];
#pragma unroll
      for (int j = 0; j < 8; ++j) { float s = 0.f;
#pragma unroll
          for (int d = 0; d < 64; ++d) s += q[d] * km[(hl * 8 + j) * 64 + d];
          gsc[j] = s; }
#pragma unroll
      for (int j = 0; j < 8; ++j) { int rank = 0;
#pragma unroll
          for (int i = 0; i < 8; ++i) if (i != j && i < qb && (gsc[i] > gsc[j] || (gsc[i] == gsc[j] && i < j))) ++rank;
          if (j < qb && rank < 3) sel |= 1u << j; } }
    float o[64], m = 0.f, l = 0.f; bool first = true;
#pragma unroll
    for (int d = 0; d < 64; ++d) o[d] = 0.f;
    for (int kb = 0; kb <= qb; ++kb)
        for (int t = 0; t < 4; ++t) {
            __syncthreads();
            { const size_t krow0 = (size_t)b * SEQ + (size_t)kb * 256 + t * 64;
#pragma unroll
              for (int i = 0; i < 2; ++i) { const int ch = tid + i * NTHR, r = ch >> 4, cc = ch & 15;
                  *(LAS v4u*)(kt + r * 128 + cc * 8) = *(const v4u*)(K + (krow0 + r) * 512 + hp * 128 + cc * 8);
                  *(LAS v4u*)(vt + r * 128 + cc * 8) = *(const v4u*)(V + (krow0 + r) * 512 + hp * 128 + cc * 8); } }
            __syncthreads();
            const bool own = (kb == qb);
            const bool act = own ? (t * 64 <= qi) : (((sel >> kb) & 1u) != 0u);
            if (act) {
                const int nk = own ? min(64, qi - t * 64 + 1) : 64;
                for (int kk = 0; kk < nk; ++kk) {
                    float s = 0.f;
#pragma unroll
                    for (int i = 0; i < 8; ++i) { const v4u x = *(const LAS v4u*)(kt + kk * 128 + hl * 64 + 8 * i);
                        s += q[8 * i + 0] * __uint_as_float(x.x << 16) + q[8 * i + 1] * __uint_as_float(x.x & 0xffff0000u) + q[8 * i + 2] * __uint_as_float(x.y << 16) + q[8 * i + 3] * __uint_as_float(x.y & 0xffff0000u)
                           + q[8 * i + 4] * __uint_as_float(x.z << 16) + q[8 * i + 5] * __uint_as_float(x.z & 0xffff0000u) + q[8 * i + 6] * __uint_as_float(x.w << 16) + q[8 * i + 7] * __uint_as_float(x.w & 0xffff0000u); }
                    if (first) { m = s; first = false; }
                    if (s > m + 8.0f) { const float f = __builtin_amdgcn_exp2f(m - s); l *= f;
#pragma unroll
                        for (int d = 0; d < 64; ++d) o[d] *= f;
                        m = s; }
                    const float p = __builtin_amdgcn_exp2f(s - m); l += p;
#pragma unroll
                    for (int i = 0; i < 8; ++i) { const v4u x = *(const LAS v4u*)(vt + kk * 128 + hl * 64 + 8 * i);
                        o[8 * i + 0] += p * __uint_as_float(x.x << 16); o[8 * i + 1] += p * __uint_as_float(x.x & 0xffff0000u); o[8 * i + 2] += p * __uint_as_float(x.y << 16); o[8 * i + 3] += p * __uint_as_float(x.y & 0xffff0000u);
                        o[8 * i + 4] += p * __uint_as_float(x.z << 16); o[8 * i + 5] += p * __uint_as_float(x.z & 0xffff0000u); o[8 * i + 6] += p * __uint_as_float(x.w << 16); o[8 * i + 7] += p * __uint_as_float(x.w & 0xffff0000u); }
                }
            }
        }
    { const float rl = 1.0f / l; bf16* op = MIX + row * 1024 + 512 + h * 64;
#pragma unroll
      for (int i = 0; i < 8; ++i) { v4u w; w.x = pk2(o[8 * i] * rl, o[8 * i + 1] * rl); w.y = pk2(o[8 * i + 2] * rl, o[8 * i + 3] * rl); w.z = pk2(o[8 * i + 4] * rl, o[8 * i + 5] * rl); w.w = pk2(o[8 * i + 6] * rl, o[8 * i + 7] * rl); *(v4u*)(op + 8 * i) = w; } }
    __syncthreads();
}
__device__ __forceinline__ void moba_sample_unit(LAS unsigned char* lds, const float* QS, const float* ksn, const float* vsn, const float* ck, const float* cv, const int* pt, const float* KMS, bf16* MIXS, int b, int h, int i) {
    const int tid = threadIdx.x, lane = tid & 63, wv = __builtin_amdgcn_readfirstlane(tid >> 6), c = lane & 15, kq = lane >> 4;
    LAS float* gl = (LAS float*)lds;
    LAS int* sel = (LAS int*)(lds + 128);
    LAS float* sc = (LAS float*)(lds + 256);
    LAS float* redw = (LAS float*)(lds + 256 + 3200);
    LAS float* redv = (LAS float*)(lds + 4096);
    const float* qrow = QS + (size_t)(4 * b + i) * 512 + h * 64;
    const f32x4 q4 = *(const f32x4*)(qrow + 4 * c);
    if (tid < 32) { const float* kmrow = KMS + ((size_t)b * 32 + tid) * 512 + h * 64; float s = 0.f;
#pragma unroll
        for (int d = 0; d < 16; ++d) s += pg8::dot4(*(const f32x4*)(qrow + 4 * d), *(const f32x4*)(kmrow + 4 * d));
        gl[tid] = s; }
    __syncthreads();
    if (tid == 0) { unsigned taken = 0;
        for (int r = 0; r < 3; ++r) { int best = -1; float bv = 0.f;
            for (int j = 0; j < 32; ++j) { if ((taken >> j) & 1u) continue; const float gj = gl[j]; if (best < 0 || gj > bv) { best = j; bv = gj; } }
            taken |= 1u << best; sel[r] = best; } }
    __syncthreads();
    const int s0 = sel[0], s1 = sel[1], s2 = sel[2];
    for (int it = 0; it < 24; ++it) { const int kk = 96 * wv + 4 * it + kq, slot = kk >> 8, pos = kk & 255; const int j = slot == 0 ? s0 : (slot == 1 ? s1 : s2);
        const int page = pt[b * NPAGES + 2 * j + (pos >> 7)];
        const f32x4 k4 = *(const f32x4*)(ck + ((size_t)page * 128 + (pos & 127)) * 512 + h * 64 + 4 * c);
        float d = pg8::dot4(q4, k4); d += __shfl_xor(d, 1); d += __shfl_xor(d, 2); d += __shfl_xor(d, 4); d += __shfl_xor(d, 8);
        if (c == 0) sc[kk] = d * 0.125f; }
    if (wv == 0 && kq <= i) { const f32x4 k4 = *(const f32x4*)(ksn + (size_t)(4 * b + kq) * 512 + h * 64 + 4 * c);
        float d = pg8::dot4(q4, k4); d += __shfl_xor(d, 1); d += __shfl_xor(d, 2); d += __shfl_xor(d, 4); d += __shfl_xor(d, 8);
        if (c == 0) sc[768 + kq] = d * 0.125f; }
    __syncthreads();
    const int n = 768 + i + 1;
    float mx = -INFINITY;
    for (int k = tid; k < n; k += NTHR) mx = fmaxf(mx, sc[k]);
    mx = wave_max(mx); if (lane == 0) redw[wv] = mx;
    __syncthreads();
    mx = redw[0];
#pragma unroll
    for (int w2 = 1; w2 < 8; ++w2) mx = fmaxf(mx, redw[w2]);
    float sm = 0.f;
    for (int k = tid; k < n; k += NTHR) { const float p = __builtin_amdgcn_exp2f((sc[k] - mx) * 1.4426950408889634f); sc[k] = p; sm += p; }
    sm = wave_sum(sm); if (lane == 0) redw[8 + wv] = sm;
    __syncthreads();
    sm = 0.f;
#pragma unroll
    for (int w2 = 0; w2 < 8; ++w2) sm += redw[8 + w2];
    f32x4 a4 = (f32x4){0.f, 0.f, 0.f, 0.f};
    for (int it = 0; it < 24; ++it) { const int kk = 96 * wv + 4 * it + kq, slot = kk >> 8, pos = kk & 255; const int j = slot == 0 ? s0 : (slot == 1 ? s1 : s2);
        const int page = pt[b * NPAGES + 2 * j + (pos >> 7)];
        const f32x4 v4 = *(const f32x4*)(cv + ((size_t)page * 128 + (pos & 127)) * 512 + h * 64 + 4 * c);
        a4 += v4 * sc[kk]; }
    if (wv == 0 && kq <= i) { const f32x4 v4 = *(const f32x4*)(vsn + (size_t)(4 * b + kq) * 512 + h * 64 + 4 * c); a4 += v4 * sc[768 + kq]; }
#pragma unroll
    for (int e = 0; e < 4; ++e) { float x = a4[e]; x += __shfl_xor(x, 16); x += __shfl_xor(x, 32); a4[e] = x; }
    if (kq == 0) *(LAS f32x4*)(redv + wv * 64 + 4 * c) = a4;
    __syncthreads();
    if (tid < 64) { float s = 0.f;
#pragma unroll
        for (int w2 = 0; w2 < 8; ++w2) s += redv[w2 * 64 + tid];
        MIXS[(size_t)(4 * b + i) * 1024 + 512 + h * 64 + tid] = (bf16)f2bf(s / sm); }
    __syncthreads();
}
struct EOrder {
    int c, nu;
    __device__ __forceinline__ bool next(int i, pg8::Unit& u) const { if (c < 128 || i >= nu) return false; u.pm = 8 * (c % 8) + (c / 8) % 8; u.pn = 2 * (c / 64 - 2) + i; return true; }
    __device__ __forceinline__ void a_ready(const pg8::Unit&) const {}
    __device__ __forceinline__ void done(const pg8::Unit&) const {}
};

#ifndef MK_N_LAUNCHES
#define MK_N_LAUNCHES 1
#endif
constexpr int N_PHASES = 7;

__global__ void __launch_bounds__(NTHR, 2) fwd(Args args) {
    extern __shared__ __attribute__((aligned(16))) unsigned char lds_raw[];
    LAS unsigned char* lds = (LAS unsigned char*)lds_raw;
    volatile LAS unsigned* MISC = (volatile LAS unsigned*)(lds + MISC_OFF);
    const int tid = threadIdx.x, lane = tid & 63, wave = __builtin_amdgcn_readfirstlane(tid >> 6);
    const int G = gridDim.x, bx = blockIdx.x, vcu = (G % 8 == 0) ? (bx % 8) * (G / 8) + bx / 8 : bx;
    unsigned char* ws = args.ws;
    unsigned* ctl = (unsigned*)(ws + WS_CTL);
    float* out = args.out;
    for (int u = tid; u < (LDS_BYTES - SCR_BYTES) / 4; u += NTHR) ((LAS unsigned*)(lds + SCR_BYTES))[u] = 0u;
    __syncthreads();
    XcdBarrier bar; bar.bar = ctl + CW_BAR; bar.x = 0; bar.st = nullptr;
    if (MK_N_LAUNCHES == 1) bar = xcd_barrier_post(ctl + CW_BAR, MISC + 8);
#define GRID_BAR() do { if (MK_N_LAUNCHES == 1) xcd_barrier(bar); } while (0)
    const int lo = args.ph_lo, hi = args.ph_hi;
#ifndef PH_MASK
#define PH_MASK 0x7f
#endif
#define IN(k) (((PH_MASK >> (k)) & 1) && lo <= (k) && (k) < hi)
#define BOTH(k) (IN(k) && IN((k) + 1))
    bf16* WIN = (bf16*)(ws + WS_WIN); bf16* WOUT = (bf16*)(ws + WS_WOUT); bf16* WUP = (bf16*)(ws + WS_WUP); bf16* WDN = (bf16*)(ws + WS_WDN); bf16* WPG = (bf16*)(ws + WS_WPG); bf16* WPP = (bf16*)(ws + WS_WPP);
    bf16* WTRIL = (bf16*)(ws + WS_WTRIL);
    float* KMP = (float*)(ws + WS_KMP); float* KMS = (float*)(ws + WS_KMS); float* SS2 = (float*)(ws + WS_SS2); float* SS3 = (float*)(ws + WS_SS3); float* SSE = (float*)(ws + WS_SSE);
    bf16* XNS = (bf16*)(ws + WS_XNS); bf16* PBS = (bf16*)(ws + WS_PBS); float* US = (float*)(ws + WS_US); float* VAS = (float*)(ws + WS_VAS); float* QS = (float*)(ws + WS_QS);
    bf16* MIXS = (bf16*)(ws + WS_MIXS); bf16* H1BS = (bf16*)(ws + WS_H1BS); bf16* HBS = (bf16*)(ws + WS_HBS); bf16* H2BS = (bf16*)(ws + WS_H2BS); float* ERS = (float*)(ws + WS_ERS);
    float* SS2S = (float*)(ws + WS_SS2S); float* SS3S = (float*)(ws + WS_SS3S);
    bf16* XN = (bf16*)(ws + WS_XN); bf16* PB = (bf16*)(ws + WS_PB); bf16* U = (bf16*)(ws + WS_U); bf16* VA = (bf16*)(ws + WS_VA); bf16* Q = (bf16*)(ws + WS_Q); bf16* K = (bf16*)(ws + WS_K); bf16* V = (bf16*)(ws + WS_V);
    bf16* MIX = (bf16*)(ws + WS_MIX); bf16* H1B = (bf16*)(ws + WS_H1B); bf16* H2B = (bf16*)(ws + WS_H2B); bf16* ER = (bf16*)(ws + WS_ER); bf16* HB = (bf16*)(ws + WS_HB);
    LAS float* RS0 = (LAS float*)(lds + RS0_OFF); LAS float* RS1 = (LAS float*)(lds + RS1_OFF);
    const int gw = vcu * NWAVES + wave, NGW = G * NWAVES;
    const int my_pm = 8 * (bx % 8) + (bx / 8) % 8;

    if (IN(0)) {
        LAS float* scr = (LAS float*)(lds + wave * 16384);
        constexpr int T_IN = 16 * 80, T_OUT = 16 * 32, T_UP = 16 * 128, T_DN = 64 * 32, T_PG = 16 * 32, T_PP = 4 * 32, NITEMS = T_IN + T_OUT + T_UP + T_DN + T_PG + T_PP;
        for (int it = gw; it < NITEMS; it += NGW) {
            int r = it;
            if (r < T_IN) { const int kb = r / 80, nb = r % 80; transpose_item(args.in[I_WIN], DM, NIN, WIN, perm_in(32 * nb), nullptr, scr, 64 * kb, 32 * nb, lane); continue; } r -= T_IN;
            if (r < T_OUT) { const int kb = r / 32, nb = r % 32; transpose_item(args.in[I_WOUT], DM, DM, WOUT, 32 * nb, nullptr, scr, 64 * kb, 32 * nb, lane); continue; } r -= T_OUT;
            if (r < T_UP) { const int kb = r / 128, nb = r % 128; transpose_item(args.in[I_WUP], DM, FF, WUP, 32 * nb, args.in[I_LN2], scr, 64 * kb, 32 * nb, lane); continue; } r -= T_UP;
            if (r < T_DN) { const int kb = r / 32, nb = r % 32; transpose_item(args.in[I_WDN], FF, DM, WDN, 32 * nb, nullptr, scr, 64 * kb, 32 * nb, lane); continue; } r -= T_DN;
            if (r < T_PG) { const int kb = r / 32, nb = r % 32; transpose_item(args.in[I_WPG], DM, DM, WPG, 32 * nb, args.in[I_LN3], scr, 64 * kb, 32 * nb, lane); continue; } r -= T_PG;
            { const int kb = r / 32, nb = r % 32; transpose_item(args.in[I_WPP], DPLE, DM, WPP, 32 * nb, nullptr, scr, 64 * kb, 32 * nb, lane); }
        }
        for (int e = gw * 64 + lane; e < 4 * 128 * 128; e += NGW * 64) { const int t = (e >> 7) & 127, s = e & 127; WTRIL[e] = (bf16)(s <= t ? f2bf(args.in[I_AWS][e]) : 0u); }
        for (int m = gw; m < MP + MS; m += NGW) {
            if (m < MP) rms_row_to_bf16(args.in[I_XP] + (size_t)m * DM, args.in[I_LN1], XN + (size_t)m * DM, lane);
            else rms_row_to_bf16(args.in[I_XS] + (size_t)(m - MP) * DM, args.in[I_LN1], XNS + (size_t)(m - MP) * DM, lane);
        }
        for (int e = gw * 64 + lane; e < (MP + MS) * DPLE / 8; e += NGW * 64) {
            const bool sm = e >= MP * DPLE / 8; const int ee = sm ? e - MP * DPLE / 8 : e;
            const float* src = (sm ? args.in[I_PS] : args.in[I_PP]) + (size_t)ee * 8; bf16* dst = (sm ? PBS : PB) + (size_t)ee * 8;
            const f32x4 a = *(const f32x4*)src, b = *(const f32x4*)(src + 4); v4u o; o.x = pk2(a.x, a.y); o.y = pk2(a.z, a.w); o.z = pk2(b.x, b.y); o.w = pk2(b.z, b.w); *(v4u*)dst = o;
        }
        { const int* pt = (const int*)args.in[I_PT]; const float* ck = args.in[I_CK]; LAS f32x4* red = (LAS f32x4*)lds;
          __syncthreads();
          for (int un = vcu; un < DBAT * 32; un += G) { const int b = un >> 5, j = un & 31; const int p0 = pt[b * NPAGES + 2 * j], p1 = pt[b * NPAGES + 2 * j + 1];
              const int cgp = tid & 127, ph = tid >> 7; f32x4 a = (f32x4){0.f, 0.f, 0.f, 0.f};
#pragma unroll 16
              for (int r = 0; r < 64; ++r) { const int rw = ph + 4 * r; const int page = rw < 128 ? p0 : p1;
                  a += __builtin_nontemporal_load((const f32x4*)(ck + ((size_t)page * 128 + (rw & 127)) * 512 + 4 * cgp)); }
              red[ph * 128 + cgp] = a;
              __syncthreads();
              if (tid < 128) { const f32x4 s = (red[tid] + red[128 + tid]) + (red[256 + tid] + red[384 + tid]); *(f32x4*)(KMS + (size_t)un * 512 + 4 * tid) = s * (1.0f / 256.0f); }
              __syncthreads(); } }
        if (BOTH(0)) GRID_BAR();
    }

    if (IN(1)) {
#ifndef P1M
#define P1M 7
#endif
        if (P1M & 1) { pg8::Gemm g{XN, WIN, MP, NIN, DM}; pg8::StaticOrder S; S.init(MP, NIN, G, bx);
          pg8::EpiIn E{U, VA, Q, K, V, out + O_KP, out + O_VP, KMP, args.in[I_QN], args.in[I_KN], C2, EPS};
          pg8::gemm_phase<pg8::EpiIn, pg8::StaticOrder, true, true>(lds, g, S, E); }
        __syncthreads();
        if (P1M & 2) { int two, kple; asm volatile("s_mov_b32 %0, 2" : "=s"(two)); asm volatile("s_mov_b32 %0, 256" : "=s"(kple)); pg8::Gemm g{PB, WPP, MP, DM, kple};
          EOrder S{bx, two}; pg8::EpiE E{ER, SSE};
          pg8::gemm_phase<pg8::EpiE, EOrder, true, true>(lds, g, S, E); }
        __syncthreads();
        if (P1M & 4) { const float* qn = args.in[I_QN]; const float* kn = args.in[I_KN]; float* kso = out + O_KS; float* vso = out + O_VS;
          auto epi_in = [=](int row, int ct, int cg, float (&v)[8]) __attribute__((always_inline)) {
              const int sec = ct >> 3, cs = (ct & 7) * 64 + 8 * cg;
              if (sec == 0 || sec == 1) {
#pragma unroll
                  for (int e = 0; e < 8; ++e) v[e] = pg8::gelu_t(v[e]);
                  st_f8((float*)(ws + (sec == 0 ? WS_US : WS_VAS)) + (size_t)row * 512 + cs, v);
              } else if (sec == 4) { st_f8(vso + (size_t)row * 512 + cs, v); }
              else { const float ss = red8(sum8sq(v)); const float rstd = 1.0f / sqrtf(ss * (1.0f / 64.0f) + EPS);
                  if (sec == 2) {
#pragma unroll
                      for (int e = 0; e < 8; ++e) v[e] = v[e] * rstd * qn[8 * cg + e];
                      st_f8(QS + (size_t)row * 512 + cs, v);
                  } else {
#pragma unroll
                      for (int e = 0; e < 8; ++e) v[e] = v[e] * rstd * kn[8 * cg + e];
                      st_f8(kso + (size_t)row * 512 + cs, v); } } };
          auto epi_e = [=](int row, int ct, int cg, float (&v)[8]) __attribute__((always_inline)) { st_f8(ERS + (size_t)row * 1024 + 64 * ct + 8 * cg, v); };
          for (int un = G - 1 - bx; un < 80 + 32; un += G) {
              if (un < 80) thin_unit<true>(lds, XNS, DM, WIN, DM, DM, un / 40, un % 40, epi_in);
              else { const int e = un - 80; thin_unit<false>(lds, PBS, DPLE, WPP, DPLE, DPLE, e / 16, e % 16, epi_e); } } }
        if (BOTH(1)) GRID_BAR();
    }

    if (IN(2)) {
        for (int un = vcu; un < 256; un += G) { const int qb = 7 - (un >> 5), r = un & 31; moba_prompt_simple(lds, Q, K, V, KMP, MIX, r >> 2, r & 3, qb); }
        for (int un = vcu; un < 512; un += G) gate_prompt_unit(lds, VA, U, WTRIL, args.in[I_AVN], args.in[I_ABS], MIX, un >> 6, (un >> 2) & 15, un & 3);
        for (int un = vcu; un < DBAT; un += G) gate_sample_unit(lds, VAS, US, args.in[I_AWS], args.in[I_AVN], args.in[I_ABS], MIXS, out + O_AV, un);
        for (int un = vcu; un < DBAT * 8 * DSEQ; un += G) moba_sample_unit(lds, QS, out + O_KS, out + O_VS, args.in[I_CK], args.in[I_CV], (const int*)args.in[I_PT], KMS, MIXS, un >> 5, (un >> 2) & 7, un & 3);
        if (BOTH(2)) GRID_BAR();
    }

    if (IN(3)) {
        { pg8::Gemm g{MIX, WOUT, MP, DM, DM}; pg8::StaticOrder S; S.init(MP, DM, G, bx); pg8::EpiRes E{args.in[I_XP], out + O_YP, H1B, SS2};
          pg8::gemm_phase<pg8::EpiRes, pg8::StaticOrder, false, true>(lds, g, S, E); }
        __syncthreads();
        { const float* xs = args.in[I_XS]; float* ys = out + O_YS;
          auto epi = [=](int row, int ct, int cg, float (&v)[8]) __attribute__((always_inline)) { const size_t off = (size_t)row * 1024 + 64 * ct + 8 * cg; const f32x4 a = *(const f32x4*)(xs + off), b = *(const f32x4*)(xs + off + 4);
              v[0] += a.x; v[1] += a.y; v[2] += a.z; v[3] += a.w; v[4] += b.x; v[5] += b.y; v[6] += b.z; v[7] += b.w;
              st_f8(ys + off, v); st_bf8(H1BS + off, v); const float ss = red8(sum8sq(v)); if (cg == 0) SS2S[row * 16 + ct] = ss; };
          for (int un = G - 1 - bx; un < 32; un += G) thin_unit<false>(lds, MIXS, DM, WOUT, DM, DM, un / 16, un % 16, epi); }
        if (BOTH(3)) GRID_BAR();
    }

    if (IN(4)) {
        if (tid < 256) { const f32x4 s = *(const f32x4*)(SS2 + (size_t)(my_pm * 256 + tid) * 4); RS0[tid] = 1.0f / sqrtf(((s.x + s.y) + (s.z + s.w)) * (1.0f / 1024.0f) + EPS); }
        __syncthreads();
        { pg8::Gemm g{H1B, WUP, MP, FF, DM}; pg8::StaticOrder S; S.init(MP, FF, G, bx); pg8::EpiUp E{HB, RS0};
          pg8::gemm_phase<pg8::EpiUp, pg8::StaticOrder, true, true>(lds, g, S, E); }
        __syncthreads();
        { auto epi = [=](int row, int ct, int cg, float (&v)[8]) __attribute__((always_inline)) { float s = 0.f;
#pragma unroll
              for (int e = 0; e < 16; ++e) s += SS2S[row * 16 + e];
              const float r = 1.0f / sqrtf(s * (1.0f / 1024.0f) + EPS);
#pragma unroll
              for (int e = 0; e < 8; ++e) { const float a = fmaxf(v[e] * r, 0.f); v[e] = a * a; }
              st_bf8(HBS + (size_t)row * FF + 64 * ct + 8 * cg, v); };
          for (int un = G - 1 - bx; un < 128; un += G) thin_unit<false>(lds, H1BS, DM, WUP, DM, DM, un / 64, un % 64, epi); }
        if (BOTH(4)) GRID_BAR();
    }

    if (IN(5)) {
        { pg8::Gemm g{HB, WDN, MP, DM, FF}; pg8::StaticOrder S; S.init(MP, DM, G, bx); pg8::EpiRes E{out + O_YP, out + O_YP, H2B, SS3};
          pg8::gemm_phase<pg8::EpiRes, pg8::StaticOrder, false, true>(lds, g, S, E); }
        __syncthreads();
        { float* ys = out + O_YS;
          auto epi = [=](int row, int ct, int cg, float (&v)[8]) __attribute__((always_inline)) { const size_t off = (size_t)row * 1024 + 64 * ct + 8 * cg; const f32x4 a = *(const f32x4*)(ys + off), b = *(const f32x4*)(ys + off + 4);
              v[0] += a.x; v[1] += a.y; v[2] += a.z; v[3] += a.w; v[4] += b.x; v[5] += b.y; v[6] += b.z; v[7] += b.w;
              st_f8(ys + off, v); st_bf8(H2BS + off, v); const float ss = red8(sum8sq(v)); if (cg == 0) SS3S[row * 16 + ct] = ss; };
          for (int un = G - 1 - bx; un < 32; un += G) thin_unit<false>(lds, HBS, FF, WDN, FF, FF, un / 16, un % 16, epi); }
        if (BOTH(5)) GRID_BAR();
    }

    if (IN(6)) {
        if (tid < 256) { const size_t row = (size_t)my_pm * 256 + tid; const f32x4 s = *(const f32x4*)(SS3 + row * 4); RS0[tid] = 1.0f / sqrtf(((s.x + s.y) + (s.z + s.w)) * (1.0f / 1024.0f) + EPS);
            float se = 0.f;
#pragma unroll
            for (int e = 0; e < 4; ++e) { const f32x4 t4 = *(const f32x4*)(SSE + row * 16 + 4 * e); se += (t4.x + t4.y) + (t4.z + t4.w); }
            RS1[tid] = 1.0f / sqrtf(se * (1.0f / 1024.0f) + EPS); }
        __syncthreads();
        { pg8::Gemm g{H2B, WPG, MP, DM, DM}; pg8::StaticOrder S; S.init(MP, DM, G, bx); pg8::EpiPle E{out + O_YP, ER, args.in[I_PLN], RS0, RS1};
          pg8::gemm_phase<pg8::EpiPle, pg8::StaticOrder, false, true>(lds, g, S, E); }
        __syncthreads();
        { float* ys = out + O_YS; const float* pln = args.in[I_PLN];
          auto epi = [=](int row, int ct, int cg, float (&v)[8]) __attribute__((always_inline)) { float s = 0.f;
#pragma unroll
              for (int e = 0; e < 16; ++e) s += SS3S[row * 16 + e];
              const float r3 = 1.0f / sqrtf(s * (1.0f / 1024.0f) + EPS);
              float se = 0.f; const float* er = ERS + (size_t)row * 1024;
              for (int e = 0; e < 256; ++e) { const f32x4 t4 = *(const f32x4*)(er + 4 * e); se += (t4.x * t4.x + t4.y * t4.y) + (t4.z * t4.z + t4.w * t4.w); }
              const float re = 1.0f / sqrtf(se * (1.0f / 1024.0f) + EPS);
              const size_t off = (size_t)row * 1024 + 64 * ct + 8 * cg;
#pragma unroll
              for (int e = 0; e < 8; ++e) { const float gt = 1.0f / (1.0f + __expf(-r3 * v[e])); v[e] = ys[off + e] + gt * (er[64 * ct + 8 * cg + e] * re * pln[64 * ct + 8 * cg + e]); }
              st_f8(ys + off, v); };
          for (int un = G - 1 - bx; un < 32; un += G) thin_unit<false>(lds, H2BS, DM, WPG, DM, DM, un / 16, un % 16, epi); }
    }
#undef IN
#undef BOTH
}

extern "C" void kernel_launch(void* const* d_in, const int* in_sizes, int n_in, void* d_out, int out_size, void* d_ws, size_t ws_size, hipStream_t stream) {
    static int grid = 0;
    if (grid == 0) {
        if (n_in != 22 || (size_t)out_size != O_END || ws_size < WS_END) { fprintf(stderr, "kernel_launch: unexpected problem shape (n_in %d, out %d, ws %zu); nothing launched\n", n_in, out_size, ws_size); grid = -1; return; }
        int dev = 0, cus = 0, per_cu = 0;
        if (hipGetDevice(&dev) != hipSuccess || hipDeviceGetAttribute(&cus, hipDeviceAttributeMultiprocessorCount, dev) != hipSuccess) { grid = -1; return; }
        if (hipFuncSetAttribute((const void*)fwd, hipFuncAttributeMaxDynamicSharedMemorySize, LDS_BYTES) != hipSuccess) { fprintf(stderr, "kernel_launch: hipFuncSetAttribute failed\n"); grid = -1; return; }
        if (hipOccupancyMaxActiveBlocksPerMultiprocessor(&per_cu, (const void*)fwd, NTHR, LDS_BYTES) != hipSuccess || per_cu < 1) fprintf(stderr, "kernel_launch: occupancy query reports %d\n", per_cu);
        (void)hipGetLastError();
        grid = cus;
        if (grid != 256) { fprintf(stderr, "kernel_launch: built for 256 CUs, found %d; nothing launched\n", cus); grid = -1; return; }
    }
    if (grid < 0) return;
    if (hipMemsetAsync((char*)d_ws + WS_CTL, 0, CTL_ZERO_BYTES, stream) != hipSuccess) return;
    Args a{};
    for (int i = 0; i < 22; ++i) a.in[i] = (const float*)d_in[i];
    a.out = (float*)d_out; a.ws = (unsigned char*)d_ws;
    for (int li = 0; li < MK_N_LAUNCHES; ++li) {
        a.ph_lo = (MK_N_LAUNCHES == 1) ? 0 : li; a.ph_hi = (MK_N_LAUNCHES == 1) ? N_PHASES : li + 1;
        hipLaunchKernelGGL(fwd, dim3(grid), dim3(NTHR), LDS_BYTES, stream, a);
    }
}
```

```cpp
#include <hip/hip_runtime.h>
#include <cstdio>
#include <cstdint>
namespace pg8 {
#define PG8_LAS __attribute__((address_space(3)))
typedef unsigned short bf16_t;
typedef short bf16x8 __attribute__((ext_vector_type(8)));
typedef float f32x4 __attribute__((ext_vector_type(4)));
typedef unsigned u32x4 __attribute__((ext_vector_type(4)));
constexpr int BM = 256, BK = 64, HALF = 128, HTB = HALF * BK * 2  , STAGE_BYTES = 8 * HTB, NXCD = 8, WGM = 8;

__host__ __device__ __forceinline__ int lds_byte(int r, int c) { const int st = (r >> 4) * 2 + (c >> 5), rr = r & 15, cc = c & 31, ob = rr * 64 + cc * 2; return st * 1024 + (ob ^ (((ob >> 9) & 1) << 5)); }
__host__ __device__ __forceinline__ void stage_rc(int b, int& R, int& C) { const int st = b / 1024, sb = b % 1024, swz = sb ^ (((sb >> 9) & 1) << 5); R = (st >> 1) * 16 + swz / 64; C = (st & 1) * 32 + (swz % 64) / 2; }
__host__ __device__ __forceinline__ int perm32(int rho) { const int n = rho >> 4, i = rho & 15; return 8 * (i >> 2) + 4 * n + (i & 3); }

struct Unit { int pm, pn; };
struct Gemm { const bf16_t* A; const bf16_t* Bt; int M, N, K; };

struct StaticOrder {
    int nM, nN, nwg, G, c;
    __host__ __device__ void init(int M, int N, int G_, int c_) { nM = M / BM; nN = N / BM; nwg = nM * nN; G = G_; c = c_; }
    __host__ __device__ bool next(int i, Unit& u) const {
        const long L = (long)i * G + c; if (L >= nwg) return false;
        int wgid = (int)L; { const int q = nwg / NXCD, r = nwg % NXCD, xcd = wgid % NXCD, off = wgid / NXCD; wgid = (xcd < r ? xcd * (q + 1) : r * (q + 1) + (xcd - r) * q) + off; }
        const int nig = WGM * nN, gid = wgid / nig, fm = gid * WGM, gsz = (nM - fm) < WGM ? (nM - fm) : WGM;
        u.pm = fm + ((wgid % nig) % gsz); u.pn = (wgid % nig) / gsz; return true;
    }
    __device__ __forceinline__ void a_ready(const Unit&) const {}
    __device__ __forceinline__ void done(const Unit&) const {}
};

__device__ __forceinline__ unsigned cvt_pk_bf16(float lo, float hi) { unsigned r; asm volatile("v_cvt_pk_bf16_f32 %0, %1, %2" : "=v"(r) : "v"(lo), "v"(hi)); return r; }
typedef float f32x2 __attribute__((ext_vector_type(2)));
__device__ __forceinline__ f32x2 gelu_pk(f32x2 v) {
    const f32x2 av = __builtin_elementwise_abs(v), d = av * 0.2316418882f + 1.0f;
    f32x2 t; t.x = __builtin_amdgcn_rcpf(d.x); t.y = __builtin_amdgcn_rcpf(d.y);
    f32x2 q = t * 0.5307027145f + (-0.7265760135f); q = q * t + 0.7107068705f; q = q * t + (-0.142248368f); q = q * t + 0.127414796f; q = q * t;
    const f32x2 s = (v * v) * (-0.72134752044f);
    f32x2 e; e.x = __builtin_amdgcn_exp2f(s.x); e.y = __builtin_amdgcn_exp2f(s.y);
    const f32x2 m = v * (q * e), r = v - m;
    f32x2 o; o.x = v.x < 0.f ? m.x : r.x; o.y = v.y < 0.f ? m.y : r.y; return o;
}

typedef float f32x2 __attribute__((ext_vector_type(2)));
typedef unsigned u32x2 __attribute__((ext_vector_type(2)));
__device__ __forceinline__ float gelu_t(float x) {
    const float u = x * (1.5957691216f + 0.0713548163f * x * x);
    const float e = __builtin_amdgcn_exp2f(-1.4426950408889634f * u);
    return x * __builtin_amdgcn_rcpf(1.0f + e);
}
__device__ __forceinline__ f32x4 gelu4(f32x4 v) { return (f32x4){gelu_t(v[0]), gelu_t(v[1]), gelu_t(v[2]), gelu_t(v[3])}; }
__device__ __forceinline__ u32x4 pack8(f32x4 a, f32x4 b) { u32x4 w; w.x = cvt_pk_bf16(a[0], a[1]); w.y = cvt_pk_bf16(a[2], a[3]); w.z = cvt_pk_bf16(b[0], b[1]); w.w = cvt_pk_bf16(b[2], b[3]); return w; }
__device__ __forceinline__ float dot4(f32x4 a, f32x4 b) { return (a[0] * b[0] + a[1] * b[1]) + (a[2] * b[2] + a[3] * b[3]); }
__device__ __forceinline__ f32x4 bf4_to_f32(u32x2 w) { return (f32x4){__uint_as_float(w.x << 16), __uint_as_float(w.x & 0xffff0000u), __uint_as_float(w.y << 16), __uint_as_float(w.y & 0xffff0000u)}; }

struct EpiIn {
    static constexpr bool PERM = true, AFTER_DRAIN = false;
    bf16_t *U, *VA, *Q, *K, *V; float *kout, *vout, *kmp; const float *qn, *kn; float c2, eps;
    __device__ __forceinline__ void operator()(const f32x4 (&acc)[2][2][4][2], const Unit& u, int wr, int wc, int fr, int fq) const {
        const int sec = u.pn >> 1;
        const int cs0 = (u.pn & 1) * 256 + wc * 64 + fq * 8;
        const int rowb = u.pm * BM + wr * 64 + fr;
#ifndef SECM
#define SECM 7
#endif
        if ((SECM & 1) && sec < 2) {
            bf16_t* O = sec == 0 ? U : VA;
#pragma unroll
            for (int ai = 0; ai < 2; ++ai)
#pragma unroll
                for (int m = 0; m < 4; ++m) { bf16_t* rowp = O + (size_t)(rowb + ai * HALF + m * 16) * 512 + cs0;
#pragma unroll
                    for (int bj = 0; bj < 2; ++bj) *(u32x4*)(rowp + 32 * bj) = pack8(gelu4(acc[ai][bj][m][0]), gelu4(acc[ai][bj][m][1])); }
        } else if ((SECM & 2) && sec == 4) {
#pragma unroll
            for (int ai = 0; ai < 2; ++ai)
#pragma unroll
                for (int m = 0; m < 4; ++m) { const size_t off = (size_t)(rowb + ai * HALF + m * 16) * 512 + cs0;
#pragma unroll
                    for (int bj = 0; bj < 2; ++bj) { const f32x4 v0 = acc[ai][bj][m][0], v1 = acc[ai][bj][m][1];
                        *(u32x4*)(V + off + 32 * bj) = pack8(v0, v1); *(f32x4*)(vout + off + 32 * bj) = v0; *(f32x4*)(vout + off + 32 * bj + 4) = v1; } }
        } else if (SECM & 4) {
            const float* gn = sec == 2 ? qn : kn; const float sc = sec == 2 ? c2 : 1.0f;
            f32x4 g[2][2], ks[2][2];
#pragma unroll
            for (int bj = 0; bj < 2; ++bj)
#pragma unroll
                for (int n = 0; n < 2; ++n) { g[bj][n] = *(const f32x4*)(gn + 32 * bj + 8 * fq + 4 * n) * sc; ks[bj][n] = (f32x4){0.f, 0.f, 0.f, 0.f}; }
#pragma unroll
            for (int ai = 0; ai < 2; ++ai)
#pragma unroll
                for (int m = 0; m < 4; ++m) {
                    float ss = (dot4(acc[ai][0][m][0], acc[ai][0][m][0]) + dot4(acc[ai][0][m][1], acc[ai][0][m][1])) + (dot4(acc[ai][1][m][0], acc[ai][1][m][0]) + dot4(acc[ai][1][m][1], acc[ai][1][m][1]));
                    ss += __shfl_xor(ss, 16); ss += __shfl_xor(ss, 32);
                    const float rstd = 1.0f / sqrtf(ss * (1.0f / 64.0f) + eps);
                    const size_t off = (size_t)(rowb + ai * HALF + m * 16) * 512 + cs0;
#pragma unroll
                    for (int bj = 0; bj < 2; ++bj) { const f32x4 o0 = acc[ai][bj][m][0] * rstd * g[bj][0], o1 = acc[ai][bj][m][1] * rstd * g[bj][1];
                        if (sec == 2) { *(u32x4*)(Q + off + 32 * bj) = pack8(o0, o1); }
                        else { *(u32x4*)(K + off + 32 * bj) = pack8(o0, o1); *(f32x4*)(kout + off + 32 * bj) = o0; *(f32x4*)(kout + off + 32 * bj + 4) = o1; ks[bj][0] += o0; ks[bj][1] += o1; } }
                }
            if (sec == 3) {
#pragma unroll
                for (int bj = 0; bj < 2; ++bj)
#pragma unroll
                    for (int n = 0; n < 2; ++n) { f32x4 s = ks[bj][n];
#pragma unroll
                        for (int e = 0; e < 4; ++e) { float x = s[e]; x += __shfl_xor(x, 1); x += __shfl_xor(x, 2); x += __shfl_xor(x, 4); x += __shfl_xor(x, 8); s[e] = x; }
                        if (fr == 0) *(f32x4*)(kmp + (size_t)(u.pm * 2 + wr) * 512 + cs0 + 32 * bj + 4 * n) = s; }
            }
        }
    }
};
struct EpiE {
    static constexpr bool PERM = true, AFTER_DRAIN = false;
    bf16_t* ER; float* sse;
    __device__ __forceinline__ void operator()(const f32x4 (&acc)[2][2][4][2], const Unit& u, int wr, int wc, int fr, int fq) const {
        const int col0 = u.pn * BM + wc * 32 + 8 * fq, rowb = u.pm * BM + wr * 64 + fr;
#pragma unroll
        for (int ai = 0; ai < 2; ++ai)
#pragma unroll
            for (int m = 0; m < 4; ++m) { const int row = rowb + ai * HALF + m * 16; float ss = 0.f;
#pragma unroll
                for (int bj = 0; bj < 2; ++bj) { const f32x4 v0 = acc[ai][bj][m][0], v1 = acc[ai][bj][m][1]; ss += dot4(v0, v0) + dot4(v1, v1);
                    *(u32x4*)(ER + (size_t)row * 1024 + col0 + bj * HALF) = pack8(v0, v1); }
                ss += __shfl_xor(ss, 16); ss += __shfl_xor(ss, 32);
                if (fq == 0) sse[(size_t)row * 16 + u.pn * 4 + wc] = ss; }
    }
};
struct EpiRes {
    static constexpr bool PERM = true, AFTER_DRAIN = true;
    const float* base; float* out; bf16_t* hb; float* ss;
    __device__ __forceinline__ void fused(f32x4 (&acc)[2][2][4][2], const Unit& u, int wr, int wc, int fr, int fq, PG8_LAS unsigned char* lds, int wid, int lane) const {
        PG8_LAS float* P = (PG8_LAS float*)lds;
        const int col0 = u.pn * BM + wc * 32 + 8 * fq;
#pragma unroll
        for (int ai = 0; ai < 2; ++ai)
#pragma unroll
            for (int m = 0; m < 4; ++m) { const int rl = ai * HALF + wr * 64 + m * 16 + fr; float s = 0.f;
#pragma unroll
                for (int bj = 0; bj < 2; ++bj) { const size_t off = (size_t)(u.pm * BM + rl) * 1024 + col0 + bj * HALF;
                    const f32x4 h0 = *(const f32x4*)(base + off) + acc[ai][bj][m][0], h1 = *(const f32x4*)(base + off + 4) + acc[ai][bj][m][1];
                    *(f32x4*)(out + off) = h0; *(f32x4*)(out + off + 4) = h1; *(u32x4*)(hb + off) = pack8(h0, h1); s += dot4(h0, h0) + dot4(h1, h1); }
                s += __shfl_xor(s, 16); s += __shfl_xor(s, 32);
                if (fq == 0) P[rl * 4 + wc] = s; }
        asm volatile("s_waitcnt lgkmcnt(0)" ::: "memory"); __builtin_amdgcn_s_barrier(); asm volatile("" ::: "memory");
        const int t = wid * 64 + lane;
        if (t < 256) { const f32x4 p = *(const PG8_LAS f32x4*)(P + t * 4); ss[(size_t)(u.pm * BM + t) * 4 + u.pn] = (p[0] + p[1]) + (p[2] + p[3]); }
    }
};
struct EpiUp {
    static constexpr bool PERM = true, AFTER_DRAIN = false;
    bf16_t* HB; const PG8_LAS float* rs;
    __device__ __forceinline__ void operator()(const f32x4 (&acc)[2][2][4][2], const Unit& u, int wr, int wc, int fr, int fq) const {
        const int col0 = u.pn * BM + wc * 32 + 8 * fq;
#pragma unroll
        for (int ai = 0; ai < 2; ++ai)
#pragma unroll
            for (int m = 0; m < 4; ++m) { const int rl = ai * HALF + wr * 64 + m * 16 + fr; const float r = rs[rl]; bf16_t* rowp = HB + (size_t)(u.pm * BM + rl) * 4096 + col0;
#pragma unroll
                for (int bj = 0; bj < 2; ++bj) { f32x4 v0 = acc[ai][bj][m][0] * r, v1 = acc[ai][bj][m][1] * r;
#pragma unroll
                    for (int e = 0; e < 4; ++e) { const float a = fmaxf(v0[e], 0.f), b = fmaxf(v1[e], 0.f); v0[e] = a * a; v1[e] = b * b; }
                    *(u32x4*)(rowp + bj * HALF) = pack8(v0, v1); } }
    }
};
struct EpiPle {
    static constexpr bool PERM = true, AFTER_DRAIN = false;
    float* y; const bf16_t* ER; const float* pn; const PG8_LAS float* rs3; const PG8_LAS float* rse;
    __device__ __forceinline__ void operator()(const f32x4 (&acc)[2][2][4][2], const Unit& u, int wr, int wc, int fr, int fq) const {
        const int col0 = u.pn * BM + wc * 32 + 8 * fq;
        f32x4 gn[2][2];
#pragma unroll
        for (int bj = 0; bj < 2; ++bj)
#pragma unroll
            for (int n = 0; n < 2; ++n) gn[bj][n] = *(const f32x4*)(pn + col0 + bj * HALF + 4 * n);
#pragma unroll
        for (int ai = 0; ai < 2; ++ai)
#pragma unroll
            for (int m = 0; m < 4; ++m) { const int rl = ai * HALF + wr * 64 + m * 16 + fr; const float r3 = rs3[rl], re = rse[rl];
#pragma unroll
                for (int bj = 0; bj < 2; ++bj) { const size_t off = (size_t)(u.pm * BM + rl) * 1024 + col0 + bj * HALF;
                    const u32x4 ew = *(const u32x4*)(ER + off); const f32x4 e0 = bf4_to_f32((u32x2){ew.x, ew.y}), e1 = bf4_to_f32((u32x2){ew.z, ew.w});
                    f32x4 y0 = *(const f32x4*)(y + off), y1 = *(const f32x4*)(y + off + 4);
#pragma unroll
                    for (int e = 0; e < 4; ++e) { const float g0 = __builtin_amdgcn_rcpf(1.0f + __builtin_amdgcn_exp2f(-1.4426950408889634f * r3 * acc[ai][bj][m][0][e]));
                        const float g1 = __builtin_amdgcn_rcpf(1.0f + __builtin_amdgcn_exp2f(-1.4426950408889634f * r3 * acc[ai][bj][m][1][e]));
                        y0[e] += g0 * (e0[e] * re * gn[bj][0][e]); y1[e] += g1 * (e1[e] * re * gn[bj][1][e]); }
                    *(f32x4*)(y + off) = y0; *(f32x4*)(y + off + 4) = y1; } }
    }
};
template <class Epi, class Sched, bool ALIGN_EPI = false, bool SP2 = false>
__device__ __forceinline__ void gemm_phase(PG8_LAS unsigned char* lds, const Gemm g, const Sched& S, const Epi& E) {
    const int tid = threadIdx.x, wid = __builtin_amdgcn_readfirstlane(tid >> 6), lane = tid & 63, wr = wid >> 2, wc = wid & 3, fr = lane & 15, fq = lane >> 4;
    const int K = g.K, nt = K / BK;
    unsigned voffA[2], voffB[2];
#pragma unroll
    for (int i = 0; i < 2; ++i) { int R, C; stage_rc(tid * 16 + i * 8192, R, C); const int Rb = Epi::PERM ? ((R & ~31) + perm32(R & 31)) : R;
        voffA[i] = (unsigned)(R * K + C) * 2u; voffB[i] = (unsigned)(Rb * K + C) * 2u; }
    const size_t kstep = (size_t)(BK * 2);
    const size_t hstep = (size_t)HALF * K * 2;
    const size_t tstep = 2 * hstep;
    const unsigned ldsw = (unsigned)wid * 1024u;
    const int aoff = lds_byte(wr * 64 + fr, fq * 8), boff = lds_byte(wc * 32 + fr, fq * 8);
#define PG8_SA(b, h) (((b) * 2 + (h)) * HTB)
#define PG8_SB(b, h) ((4 + (b) * 2 + (h)) * HTB)
#define PG8_STAGE(bufoff, gbase, voff) do { _Pragma("unroll") for (int _i = 0; _i < 2; ++_i) \
        __builtin_amdgcn_global_load_lds((const unsigned*)((const char*)(gbase) + (voff)[_i]), (PG8_LAS unsigned*)(lds + (bufoff) + ldsw + _i * 8192), 16, 0, 0); } while (0)
#define PG8_LDA(dst, b, h) do { _Pragma("unroll") for (int m = 0; m < 4; ++m) _Pragma("unroll") for (int k = 0; k < 2; ++k) dst[m][k] = *(const PG8_LAS bf16x8*)(lds + PG8_SA(b, h) + aoff + m * 2048 + k * 1024); } while (0)
#define PG8_LDB(dst, b, h) do { _Pragma("unroll") for (int n = 0; n < 2; ++n) _Pragma("unroll") for (int k = 0; k < 2; ++k) dst[n][k] = *(const PG8_LAS bf16x8*)(lds + PG8_SB(b, h) + boff + n * 2048 + k * 1024); } while (0)
#define PG8_MMA(ai, bj, At, Bt) do { __builtin_amdgcn_s_setprio(1); _Pragma("unroll") for (int m = 0; m < 4; ++m) _Pragma("unroll") for (int n = 0; n < 2; ++n) _Pragma("unroll") for (int k = 0; k < 2; ++k) \
        acc[ai][bj][m][n] = __builtin_amdgcn_mfma_f32_16x16x32_bf16(Bt[n][k], At[m][k], acc[ai][bj][m][n], 0, 0, 0); __builtin_amdgcn_s_setprio(0); } while (0)
#define PG8_WAIT_V(n) asm volatile("s_waitcnt vmcnt(" #n ")" ::: "memory")
#define PG8_WAIT_L(n) asm volatile("s_waitcnt lgkmcnt(" #n ")" ::: "memory")
#define PG8_BAR __builtin_amdgcn_s_barrier()
#define PG8_SCHED __builtin_amdgcn_sched_barrier(0)
    Unit cur, nxt; int ui = 0;
    if (!S.next(0, cur)) return;
    f32x4 acc[2][2][4][2];
#pragma unroll
    for (int a = 0; a < 2; ++a)
#pragma unroll
        for (int b = 0; b < 2; ++b)
#pragma unroll
            for (int m = 0; m < 4; ++m)
#pragma unroll
                for (int n = 0; n < 2; ++n) acc[a][b][m][n] = (f32x4){0.f, 0.f, 0.f, 0.f};
    bf16x8 At[4][2], B0[2][2], B1[2][2];
    const char* cA = (const char*)g.A + (size_t)cur.pm * tstep; const char* cB = (const char*)g.Bt + (size_t)cur.pn * tstep;
    S.a_ready(cur);
    if constexpr (SP2) {
        PG8_STAGE(PG8_SB(0, 0), cB, voffB); PG8_STAGE(PG8_SB(0, 1), cB + hstep, voffB); PG8_STAGE(PG8_SA(0, 0), cA, voffA); PG8_STAGE(PG8_SA(0, 1), cA + hstep, voffA);
        if (wr == 1) PG8_BAR;
        PG8_WAIT_V(2); PG8_BAR;
        PG8_STAGE(PG8_SB(1, 0), cB + kstep, voffB); PG8_STAGE(PG8_SA(1, 0), cA + kstep, voffA); PG8_STAGE(PG8_SB(1, 1), cB + hstep + kstep, voffB);
        PG8_WAIT_V(6); PG8_BAR;
    } else {
        PG8_STAGE(PG8_SB(0, 0), cB, voffB); PG8_STAGE(PG8_SA(0, 0), cA, voffA); PG8_STAGE(PG8_SB(0, 1), cB + hstep, voffB); PG8_STAGE(PG8_SA(0, 1), cA + hstep, voffA);
        if (wr == 1) PG8_BAR;
        PG8_WAIT_V(4); PG8_BAR;
        PG8_STAGE(PG8_SB(1, 0), cB + kstep, voffB); PG8_STAGE(PG8_SA(1, 0), cA + kstep, voffA); PG8_STAGE(PG8_SB(1, 1), cB + hstep + kstep, voffB);
        PG8_WAIT_V(6); PG8_BAR;
    }
    for (;;) {
        const bool has_next = S.next(ui + 1, nxt);
        const char* nA = has_next ? (const char*)g.A + (size_t)nxt.pm * tstep : cA; const char* nB = has_next ? (const char*)g.Bt + (size_t)nxt.pn * tstep : cB;
        for (int t = 0; t < nt; t += 2) {
            const bool last = (t == nt - 2);
            const char* a1 = cA + (size_t)(t + 1) * kstep;
            const char* a2 = last ? nA : cA + (size_t)(t + 2) * kstep; const char* b2 = last ? nB : cB + (size_t)(t + 2) * kstep;
            const char* a3 = a2 + kstep; const char* b3 = b2 + kstep;
            if (last && has_next) S.a_ready(nxt);
            if constexpr (SP2) {
            PG8_LDB(B0, 0, 0); PG8_LDB(B1, 0, 1); PG8_SCHED; PG8_LDA(At, 0, 0); PG8_STAGE(PG8_SA(1, 1), a1 + hstep, voffA);
            PG8_WAIT_V(8); PG8_WAIT_L(0); PG8_BAR; PG8_MMA(0, 0, At, B0); PG8_MMA(0, 1, At, B1); PG8_BAR; PG8_SCHED;
            PG8_LDA(At, 0, 1); PG8_STAGE(PG8_SB(0, 0), b2, voffB); PG8_STAGE(PG8_SB(0, 1), b2 + hstep, voffB); PG8_STAGE(PG8_SA(0, 0), a2, voffA);
            PG8_WAIT_V(8); PG8_WAIT_L(0); PG8_BAR; PG8_MMA(1, 0, At, B0); PG8_MMA(1, 1, At, B1); PG8_BAR; PG8_SCHED;
            PG8_LDB(B0, 1, 0); PG8_LDB(B1, 1, 1); PG8_SCHED; PG8_LDA(At, 1, 0); PG8_STAGE(PG8_SA(0, 1), a2 + hstep, voffA);
            PG8_WAIT_V(8); PG8_WAIT_L(0); PG8_BAR; PG8_MMA(0, 0, At, B0); PG8_MMA(0, 1, At, B1); PG8_BAR; PG8_SCHED;
            PG8_LDA(At, 1, 1); PG8_STAGE(PG8_SB(1, 0), b3, voffB); PG8_STAGE(PG8_SB(1, 1), b3 + hstep, voffB); PG8_STAGE(PG8_SA(1, 0), a3, voffA);
            PG8_WAIT_V(8); PG8_WAIT_L(0); PG8_BAR; PG8_MMA(1, 0, At, B0); PG8_MMA(1, 1, At, B1); PG8_BAR; PG8_SCHED;
            } else {
            PG8_LDB(B0, 0, 0); PG8_SCHED; PG8_LDA(At, 0, 0); PG8_STAGE(PG8_SA(1, 1), a1 + hstep, voffA);
            PG8_WAIT_L(8); PG8_BAR; PG8_WAIT_L(0); PG8_MMA(0, 0, At, B0); PG8_BAR; PG8_SCHED;
            PG8_LDB(B1, 0, 1); PG8_STAGE(PG8_SB(0, 0), b2, voffB);
            PG8_BAR; PG8_WAIT_L(0); PG8_MMA(0, 1, At, B1); PG8_BAR;
            PG8_LDA(At, 0, 1); PG8_STAGE(PG8_SA(0, 0), a2, voffA);
            PG8_BAR; PG8_WAIT_L(0); PG8_MMA(1, 0, At, B0); PG8_BAR; PG8_SCHED;
            PG8_STAGE(PG8_SB(0, 1), b2 + hstep, voffB);
            PG8_WAIT_V(6); PG8_BAR; PG8_MMA(1, 1, At, B1); PG8_BAR;
            PG8_LDB(B0, 1, 0); PG8_SCHED; PG8_LDA(At, 1, 0); PG8_STAGE(PG8_SA(0, 1), a2 + hstep, voffA);
            PG8_WAIT_L(8); PG8_BAR; PG8_WAIT_L(0); PG8_MMA(0, 0, At, B0); PG8_BAR; PG8_SCHED;
            PG8_LDB(B1, 1, 1); PG8_STAGE(PG8_SB(1, 0), b3, voffB);
            PG8_BAR; PG8_WAIT_L(0); PG8_MMA(0, 1, At, B1); PG8_BAR;
            PG8_LDA(At, 1, 1); PG8_STAGE(PG8_SA(1, 0), a3, voffA);
            PG8_BAR; PG8_WAIT_L(0); PG8_MMA(1, 0, At, B0); PG8_BAR; PG8_SCHED;
            PG8_STAGE(PG8_SB(1, 1), b3 + hstep, voffB);
            PG8_WAIT_V(6); PG8_BAR; PG8_MMA(1, 1, At, B1); PG8_BAR;
            }
        }
        if constexpr (ALIGN_EPI) { if (wr == 0) PG8_BAR; }
        if constexpr (!Epi::AFTER_DRAIN) { E(acc, cur, wr, wc, fr, fq); S.done(cur); }
        if (!has_next) break;
#pragma unroll
        for (int a = 0; a < 2; ++a)
#pragma unroll
            for (int b = 0; b < 2; ++b)
#pragma unroll
                for (int m = 0; m < 4; ++m)
#pragma unroll
                    for (int n = 0; n < 2; ++n) acc[a][b][m][n] = (f32x4){0.f, 0.f, 0.f, 0.f};
        cur = nxt; cA = nA; cB = nB; ++ui;
        if constexpr (ALIGN_EPI) { if (wr == 1) PG8_BAR; }
    }
    PG8_WAIT_V(0);
    if constexpr (!ALIGN_EPI) { if (wr == 0) PG8_BAR; }
    PG8_BAR;
    if constexpr (Epi::AFTER_DRAIN) { E.fused(acc, cur, wr, wc, fr, fq, lds, wid, lane); S.done(cur); }
#undef PG8_SA
#undef PG8_SB
#undef PG8_STAGE
#undef PG8_LDA
#undef PG8_LDB
#undef PG8_MMA
#undef PG8_WAIT_V
#undef PG8_WAIT_L
#undef PG8_BAR
#undef PG8_SCHED
}
}
#ifndef PG8_SP2
#define PG8_SP2 true
#endif
#define GAS __attribute__((address_space(1)))
#define LAS __attribute__((address_space(3)))
typedef unsigned short bf16;
typedef unsigned v4u __attribute__((ext_vector_type(4)));
typedef float f32x4 __attribute__((ext_vector_type(4)));
typedef short bf16x8 __attribute__((ext_vector_type(8)));
typedef GAS unsigned gu32;
typedef GAS unsigned long long gu64;
#define RLX_AGENT __ATOMIC_RELAXED, __HIP_MEMORY_SCOPE_AGENT
#define LDS_WAIT() asm volatile("s_waitcnt lgkmcnt(0)" ::: "memory")
#define VM_WAIT() asm volatile("s_waitcnt vmcnt(0)" ::: "memory")
__device__ __forceinline__ unsigned long long rt() { return __builtin_amdgcn_s_memrealtime(); }
__device__ __forceinline__ unsigned f2bf(float f) { unsigned u = __builtin_bit_cast(unsigned, f); return (u + 0x7fffu + ((u >> 16) & 1u)) >> 16; }
__device__ __forceinline__ unsigned pk2(float lo, float hi) { return f2bf(lo) | (f2bf(hi) << 16); }

#define XB_TMO      128
#define XB_XCNT(j)  (256  + 64 * (j))
#define XB_XSUB(j)  (1280 + 64 * (j))
#define XB_XGEN(j)  (2304 + 64 * (j))
#define XB_TOP      3328
#define XB_TOPGEN   3392
#define XCD_BAR_WORDS 3456
#define XB_SPIN_CAP (1u << 18)

__device__ __forceinline__ unsigned xb_ld(unsigned* p)              { return __hip_atomic_load(p, __ATOMIC_RELAXED, __HIP_MEMORY_SCOPE_AGENT); }
__device__ __forceinline__ unsigned xb_add(unsigned* p, unsigned v) { return __hip_atomic_fetch_add(p, v, __ATOMIC_RELAXED, __HIP_MEMORY_SCOPE_AGENT); }
__device__ __forceinline__ unsigned xb_xcc_id() { return (unsigned)__builtin_amdgcn_s_getreg((3 << 11) | 20) & 0xFu; }
#define XB_SPIN(cond, bar) do { unsigned _sp = 0; while (cond) { __builtin_amdgcn_s_sleep(1); \
    if ((++_sp & 255u) == 0u) { if (xb_ld(&(bar)[XB_TMO])) break; if (_sp > XB_SPIN_CAP) { atomicAdd(&(bar)[XB_TMO], 1u); break; } } } } while (0)

struct XcdBarrier {
    unsigned* bar; unsigned x;
    volatile LAS unsigned* st;
};

__device__ __forceinline__ XcdBarrier xcd_barrier_post(unsigned* bar, volatile LAS unsigned* st) {
    XcdBarrier b; b.bar = bar; b.x = xb_xcc_id(); b.st = st;
    if (threadIdx.x == 0) (void)xb_add(&bar[XB_XCNT(b.x)], 1u);
    return b;
}
__device__ __forceinline__ void xcd_barrier_complete(unsigned* bar, unsigned x, unsigned& nloc, unsigned& nx) {
    const unsigned G = gridDim.x * gridDim.y * gridDim.z;
    unsigned sum, cnt, mine, sp = 0u;
    for (;;) {
        sum = 0u; cnt = 0u; mine = 0u;
#pragma unroll
        for (unsigned j = 0; j < 16; ++j) { const unsigned c = xb_ld(&bar[XB_XCNT(j)]); sum += c; cnt += (c > 0u) ? 1u : 0u; mine = (j == x) ? c : mine; }
        if (sum == G) break;
        __builtin_amdgcn_s_sleep(1);
        if ((++sp & 255u) == 0u) { if (xb_ld(&bar[XB_TMO])) break; if (sp > XB_SPIN_CAP) { atomicAdd(&bar[XB_TMO], 1u); break; } }
    }
    nloc = mine > 0u ? mine : 1u; nx = cnt > 0u ? cnt : 1u;
}

__device__ __forceinline__ void xcd_barrier(const XcdBarrier& b) {
    asm volatile("s_waitcnt vmcnt(0)" ::: "memory");
    __syncthreads();
    if (threadIdx.x == 0) {
        unsigned* bar = b.bar;
        __builtin_amdgcn_s_waitcnt(0);
        unsigned nloc = b.st[0], nx = b.st[1];
        if (nloc == 0u) { xcd_barrier_complete(bar, b.x, nloc, nx); b.st[0] = nloc; b.st[1] = nx; }
        const unsigned old = xb_add(&bar[XB_XSUB(b.x)], 1u);
        const unsigned gen = old / nloc;
        if (old + 1u == (gen + 1u) * nloc) {
            __builtin_amdgcn_fence(__ATOMIC_RELEASE, "agent");
            asm volatile("s_waitcnt vmcnt(0)" ::: "memory");
            const unsigned og = xb_add(&bar[XB_TOP], 1u);
            const unsigned tg = og / nx;
            if (og + 1u == (tg + 1u) * nx) xb_add(&bar[XB_TOPGEN], 1u);
            else XB_SPIN(xb_ld(&bar[XB_TOPGEN]) == tg, bar);
            __builtin_amdgcn_fence(__ATOMIC_ACQUIRE, "agent");
            xb_add(&bar[XB_XGEN(b.x)], 1u);
            asm volatile("s_waitcnt vmcnt(0)" ::: "memory");
        } else {
            XB_SPIN(xb_ld(&bar[XB_XGEN(b.x)]) == gen, bar);
            __builtin_amdgcn_fence(__ATOMIC_ACQUIRE, "agent");
            asm volatile("s_waitcnt vmcnt(0)" ::: "memory");
        }
    }
    __syncthreads();
}
typedef unsigned u32x2 __attribute__((ext_vector_type(2)));
#include <hip/hip_bf16.h>
#include <cmath>
namespace attn_body {
using bf16=__hip_bfloat16;
using bf16x8=__attribute__((ext_vector_type(8)))short;
using s16x4=__attribute__((ext_vector_type(4)))short;
using f32x16=__attribute__((ext_vector_type(16)))float;
using u32x4=__attribute__((ext_vector_type(4)))unsigned;
using f32x4_t=__attribute__((ext_vector_type(4)))float;
constexpr int BATCH=8,NHEAD=8,SEQ=2048,D=64,DM=NHEAD*D,OP=1024,OCOL=512;
constexpr int NW=8,QBLK=32,QB=QBLK*NW,KVBLK=64,NQB=SEQ/QB;
constexpr int ATTN_PITCH=DM, ATTN_UNIT_ROWS=QB;
__device__ __forceinline__ int crow(int r,int hi){return (r&3)+8*(r>>2)+4*hi;}
#define SBAR() __builtin_amdgcn_sched_barrier(0)
__device__ __forceinline__ void cmask(f32x16&p0,f32x16&p1,int jb,int qrel,int hi){
  const float NEG=-INFINITY; int lim=qrel-(64*jb+4*hi); asm volatile("":"+v"(lim));
  #pragma unroll
  for(int r=0;r<16;++r){const int c=(r&3)+8*(r>>2); if(c>lim)p0[r]=NEG; if(c+32>lim)p1[r]=NEG;}
}

constexpr int NSLOT=3, SLOTB=8192;
constexpr int LDS_K=0, LDS_V=NSLOT*SLOTB, LDS_WS=2*NSLOT*SLOTB, LDS_OST=LDS_WS+NW*64*4, LDS_KM=LDS_OST+NW*4096, LDS_BYTES=LDS_KM+7*64*4;
constexpr float C2=0.125f*1.4426950408889634f;
__device__ __forceinline__ void glds16(const void*gsrc,unsigned lds_dst){unsigned keep;
  asm volatile("s_mov_b32 %0, m0\n\ts_mov_b32 m0, %2\n\ts_nop 0\n\tglobal_load_lds_dwordx4 %1, off\n\ts_mov_b32 m0, %0":"=&s"(keep):"v"(gsrc),"s"(lds_dst):"memory");}
__device__ __forceinline__ float max3f(float a,float b,float c){float r;asm("v_max3_f32 %0, %1, %2, %3":"=v"(r):"v"(a),"v"(b),"v"(c));return r;}
__device__ __forceinline__ float max2f(float a,float b){float r;asm("v_max_f32_e32 %0, %1, %2":"=v"(r):"v"(a),"v"(b));return r;}
__device__ __forceinline__ float fadd_s(float a,float b){float r;asm("v_add_f32_e32 %0, %1, %2":"=v"(r):"v"(a),"v"(b));return r;}
__device__ __forceinline__ float fsub_s(float a,float b){float r;asm("v_sub_f32_e32 %0, %1, %2":"=v"(r):"v"(a),"v"(b));return r;}
typedef float f32x2_t __attribute__((ext_vector_type(2))); typedef __bf16 bf16x2_t __attribute__((ext_vector_type(2)));
__device__ __forceinline__ unsigned cvtpk_s(float lo,float hi){f32x2_t v={lo,hi};bf16x2_t b=__builtin_convertvector(v,bf16x2_t);return __builtin_bit_cast(unsigned,b);}
#define WAIT_BAR(N) asm volatile("s_waitcnt vmcnt(" #N ") lgkmcnt(0)\n\ts_barrier":::"memory")

__device__ __forceinline__ void qkt(f32x16&p0,f32x16&p1,const char*Kslot,const bf16x8*qr,const f32x16&negm,int r32,int hi){
  const char*kb=Kslot+hi*1024+r32*16;
  #pragma unroll
  for(int d0=0;d0<4;++d0){
    const bf16x8 b0=*reinterpret_cast<const bf16x8*>(kb+d0*2048);
    const bf16x8 b1=*reinterpret_cast<const bf16x8*>(kb+d0*2048+512);
    if(d0==0){p0=__builtin_amdgcn_mfma_f32_32x32x16_bf16(b0,qr[0],negm,0,0,0);p1=__builtin_amdgcn_mfma_f32_32x32x16_bf16(b1,qr[0],negm,0,0,0);}
    else{p0=__builtin_amdgcn_mfma_f32_32x32x16_bf16(b0,qr[d0],p0,0,0,0);p1=__builtin_amdgcn_mfma_f32_32x32x16_bf16(b1,qr[d0],p1,0,0,0);}}
}
typedef __attribute__((address_space(3))) const char* lds_cptr;
typedef short v4i16_t __attribute__((ext_vector_type(4)));
__device__ __forceinline__ void kload8(bf16x8*kf,lds_cptr kp){
  kf[0]=*(const __attribute__((address_space(3))) bf16x8*)(kp);      kf[1]=*(const __attribute__((address_space(3))) bf16x8*)(kp+512);
  kf[2]=*(const __attribute__((address_space(3))) bf16x8*)(kp+2048); kf[3]=*(const __attribute__((address_space(3))) bf16x8*)(kp+2560);
  kf[4]=*(const __attribute__((address_space(3))) bf16x8*)(kp+4096); kf[5]=*(const __attribute__((address_space(3))) bf16x8*)(kp+4608);
  kf[6]=*(const __attribute__((address_space(3))) bf16x8*)(kp+6144); kf[7]=*(const __attribute__((address_space(3))) bf16x8*)(kp+6656);
}
__device__ __forceinline__ void kload2(bf16x8*kf,lds_cptr kp,int j){ kf[2*j]=*(const __attribute__((address_space(3))) bf16x8*)(kp+j*2048); kf[2*j+1]=*(const __attribute__((address_space(3))) bf16x8*)(kp+j*2048+512); }
__device__ __forceinline__ s16x4 vtr(lds_cptr p){ return __builtin_bit_cast(s16x4,__builtin_amdgcn_ds_read_tr16_b64_v4i16((__attribute__((address_space(3))) v4i16_t*)p)); }
__device__ __forceinline__ float rowmax(const f32x16&p0,const f32x16&p1){
  float a=max3f(p0[0],p0[1],p1[0]),b=max3f(p0[2],p0[3],p1[1]);a=max3f(a,p1[2],p1[3]);
  #pragma unroll
  for(int r=4;r<16;r+=4){a=max3f(a,p0[r],p0[r+1]);b=max3f(b,p0[r+2],p0[r+3]);a=max3f(a,p1[r],p1[r+1]);b=max3f(b,p1[r+2],p1[r+3]);}
  const float m=max2f(a,b);
  auto rr=__builtin_amdgcn_permlane32_swap(__float_as_uint(m),__float_as_uint(m),false,false);
  return max2f(__uint_as_float(rr[0]),__uint_as_float(rr[1]));
}
__device__ __forceinline__ void pv(f32x16*o,int vb,bf16x8 pa0,bf16x8 pa1,bf16x8 pa2,bf16x8 pa3){
  #pragma unroll
  for(int d0=0;d0<2;++d0){s16x4 lo[4],hi[4];
    #pragma unroll
    for(int ks=0;ks<4;++ks){
      asm volatile("ds_read_b64_tr_b16 %0,%1 offset:%c2":"=&v"(lo[ks]):"v"(vb),"i"(d0*4096+ks*1024):"memory");
      asm volatile("ds_read_b64_tr_b16 %0,%1 offset:%c2":"=&v"(hi[ks]):"v"(vb),"i"(d0*4096+ks*1024+512):"memory");}
    asm volatile("s_waitcnt lgkmcnt(0)":::"memory");SBAR();
    #define PK(k) (bf16x8){lo[k][0],lo[k][1],lo[k][2],lo[k][3],hi[k][0],hi[k][1],hi[k][2],hi[k][3]}
    o[d0]=__builtin_amdgcn_mfma_f32_32x32x16_bf16(pa0,PK(0),o[d0],0,0,0);
    o[d0]=__builtin_amdgcn_mfma_f32_32x32x16_bf16(pa1,PK(1),o[d0],0,0,0);
    o[d0]=__builtin_amdgcn_mfma_f32_32x32x16_bf16(pa2,PK(2),o[d0],0,0,0);
    o[d0]=__builtin_amdgcn_mfma_f32_32x32x16_bf16(pa3,PK(3),o[d0],0,0,0);
    #undef PK
  }
}

#ifndef ATTN_STORE16
#define ATTN_STORE16(p,v) (*(u32x4*)(p)=(v))
#endif
template<int THRL> __device__ __forceinline__ void attn_unit(int b,int h,int qb,const bf16*Q,const bf16*__restrict__ K,const bf16*__restrict__ V,bf16*O,const float*__restrict__ KMP,char*shm){
  const int tid=threadIdx.x,lane=tid&63,r32=lane&31,hi=lane>>5; const int wid=__builtin_amdgcn_readfirstlane(tid>>6);
  const long rowbase=(long)b*SEQ; const int q0=qb*QB;
  const bf16*Qw=Q+(rowbase+q0+wid*QBLK)*DM+h*D;
  const bf16*Kh=K+rowbase*DM+h*D,*Vh=V+rowbase*DM+h*D;
  const unsigned lds0=(unsigned)(uintptr_t)shm;
  float*wsf=(float*)(shm+LDS_WS)+wid*64;
  const bf16*ksrc=Kh+(long)lane*DM+wid*8;
  const bf16*vsrc=Vh+(long)(16*(wid&3)+(lane>>2))*DM+(wid>>2)*32+(lane&3)*8;
  const unsigned kdst=lds0+LDS_K+wid*1024, vdst=lds0+LDS_V+wid*1024;
  #define DMA_K(t,slot) glds16(ksrc+(long)TMAP(t)*KVBLK*DM,(unsigned)__builtin_amdgcn_readfirstlane(kdst+(slot)))
  #define DMA_V(t,slot) glds16(vsrc+(long)TMAP(t)*KVBLK*DM,(unsigned)__builtin_amdgcn_readfirstlane(vdst+(slot)))
  const int vb0=(int)(lds0+LDS_V)+((lane>>4)&1)*32+(lane&3)*8+(4*hi+((lane&15)>>2))*64;
  const char*Kbase=shm+LDS_K; bf16x8 kf[8];
  const lds_cptr shm3=(lds_cptr)shm; const lds_cptr kp0=shm3+LDS_K+hi*1024+r32*16; const lds_cptr vp0=shm3+LDS_V+((lane>>4)&1)*32+(lane&3)*8+(4*hi+((lane&15)>>2))*64;
  const int NT=(q0+QB)/KVBLK;
  #define TMAP(t) ((t)<4?NT-4+(t):(t)-4)
  __attribute__((address_space(3))) float*kmf=(__attribute__((address_space(3))) float*)((__attribute__((address_space(3))) char*)shm+LDS_KM);
  if(tid<qb*64){const int j=tid>>6,d=tid&63;const float*kp=KMP+(long)((b*8+j)*2)*512+h*64+d;kmf[tid]=(kp[0]+kp[512])*(1.0f/256.0f);}
  DMA_K(0,0);DMA_V(0,0);DMA_K(1,SLOTB);
  bf16x8 qr[4];
  #pragma unroll
  for(int d0=0;d0<4;++d0)qr[d0]=*reinterpret_cast<const bf16x8*>(&Qw[(long)r32*DM+d0*16+hi*8]);
  float mhat=0.f,l_reg=0.f;f32x16 o[2],negm;{float z_=0.f;asm volatile("":"+v"(z_)); _Pragma("unroll") for(int r=0;r<16;++r){o[0][r]=z_;o[1][r]=z_;negm[r]=z_;}}asm volatile("":"+v"(negm));
  const int qrel=wid*QBLK+r32;
  #define CMASK(P0,P1,t) do{ if((t)<4)cmask(P0,P1,(t),qrel,hi); }while(0)
  bool resc=false;
  #define START(P0,P1) do{ const float rm=rowmax(P0,P1); resc=false; \
    { const float dl=rm; mhat=fadd_s(mhat,dl); \
      _Pragma("unroll") for(int r=0;r<16;++r){P0[r]=fsub_s(P0[r],dl);P1[r]=fsub_s(P1[r],dl);} \
      _Pragma("unroll") for(int r=0;r<16;++r)negm[r]=-mhat; asm volatile("":"+v"(negm)); } \
    _Pragma("unroll") for(int r=0;r<16;++r)P0[r]=__builtin_amdgcn_exp2f(P0[r]); }while(0)
  #define RESC() do{ if(resc){ asm volatile("s_waitcnt lgkmcnt(0)":::"memory"); \
      _Pragma("unroll") for(int d_=0;d_<2;++d_) _Pragma("unroll") for(int r=0;r<16;++r)o[d_][r]*=wsf[crow(r,hi)]; } }while(0)
  f32x16 pA0,pA1,pB0,pB1;
  int sl_prev=0,sl_cur=0,sl_next=SLOTB;
  #define ROT() do{sl_prev=sl_cur;sl_cur=sl_next;sl_next=(sl_next==(NSLOT-1)*SLOTB)?0:sl_next+SLOTB;}while(0)
  DMA_K(2,2*SLOTB);
  WAIT_BAR(3);
  unsigned sel=0xffu; bool selc=true;
  if(qb>=4){ float g[7];
    _Pragma("unroll") for(int j=0;j<7;++j){ float s=-INFINITY;
      if(j<qb){ s=0.f; _Pragma("unroll") for(int d0=0;d0<4;++d0){ const __attribute__((address_space(3))) float*kp=kmf+j*64+16*d0+8*hi; const f32x4_t a=*(const __attribute__((address_space(3))) f32x4_t*)kp,c=*(const __attribute__((address_space(3))) f32x4_t*)(kp+4);
          _Pragma("unroll") for(int e=0;e<4;++e){ s+=__uint_as_float((unsigned)(unsigned short)qr[d0][e]<<16)*a[e]; s+=__uint_as_float((unsigned)(unsigned short)qr[d0][4+e]<<16)*c[e]; } }
        auto rr=__builtin_amdgcn_permlane32_swap(__float_as_uint(s),__float_as_uint(s),false,false); s=__uint_as_float(rr[0])+__uint_as_float(rr[1]); }
      g[j]=s; }
    sel=0u;
    _Pragma("unroll") for(int j=0;j<7;++j){ int rank=0; _Pragma("unroll") for(int i=0;i<7;++i) if(i!=j) rank+=(g[i]>g[j]||(g[i]==g[j]&&i<j))?1:0; if(j<qb&&rank<3)sel|=1u<<j; } }
  qkt(pA0,pA1,Kbase,qr,negm,r32,hi);asm volatile("s_nop 15\n\ts_nop 7":"+v"(pA0),"+v"(pA1));CMASK(pA0,pA1,0);
  START(pA0,pA1);
  _Pragma("unroll") for(int r=0;r<16;++r)pA1[r]=__builtin_amdgcn_exp2f(pA1[r]);
  WAIT_BAR(0);
  DMA_K(3,0);DMA_V(1,SLOTB);
  ROT();
  kload8(kf,kp0+sl_cur);
  WAIT_BAR(2);
  s16x4 vlo[8],vhi[8]; u32x4 pw0,pw1,pw2,pw3;
  #define PKW(P,B) cvtpk_s(P[B],P[B+1])
  #define PAF(k) __builtin_bit_cast(bf16x8,pw##k)
  #define VFR(i) (bf16x8){vlo[i][0],vlo[i][1],vlo[i][2],vlo[i][3],vhi[i][0],vhi[i][1],vhi[i][2],vhi[i][3]}
  #define PIN(x) asm volatile("":"+v"(x))
  #define MX3(a,b,c) __builtin_fmaxf(__builtin_fmaxf((a),(b)),(c))
  #define GAPA(MF,A0,A1,A2,A3,W0,W1,PW) do{ MF; sacc+=A0; sacc+=A1; sacc+=A2; sacc+=A3; PIN(sacc); W0; W1; PIN(PW); SBAR(); }while(0)
  #define EX(v) __builtin_amdgcn_exp2f(v)
  #define GAPB(MF,X,B) do{ MF; X[B]=EX(X[B]); X[B+1]=EX(X[B+1]); X[B+2]=EX(X[B+2]); X[B+3]=EX(X[B+3]); PIN(X); SBAR(); }while(0)
  #define VRD(i) do{ vlo[i]=vtr(vp_+(((i)>>2)*4096+((i)&3)*1024)); vhi[i]=vtr(vp_+(((i)>>2)*4096+((i)&3)*1024+512)); }while(0)
  #define KRD(G,j) do{ if(G){ kload2(kf,kp0+sl_next,j); SBAR(); } }while(0)
  #define STEP(C0,C1,P0,P1,t,GK,GV,GL) do{ SBAR(); \
    const lds_cptr vp_=vp0+sl_prev; \
    VRD(0); SBAR(); float sacc=(P0[0]+P0[1]); \
    GAPA(C0=__builtin_amdgcn_mfma_f32_32x32x16_bf16(kf[0],qr[0],negm,0,0,0), P0[2],P0[3],P0[4],P0[5],     pw0[0]=PKW(P0,0), pw0[1]=PKW(P0,2), pw0); \
    VRD(4); SBAR(); GAPA(C1=__builtin_amdgcn_mfma_f32_32x32x16_bf16(kf[1],qr[0],negm,0,0,0), P0[6],P0[7],P0[8],P0[9],     pw0[2]=PKW(P0,4), pw0[3]=PKW(P0,6), pw0); \
    VRD(1); SBAR(); GAPA(C0=__builtin_amdgcn_mfma_f32_32x32x16_bf16(kf[2],qr[1],C0,0,0,0),   P0[10],P0[11],P0[12],P0[13], pw1[0]=PKW(P0,8), pw1[1]=PKW(P0,10), pw1); \
    VRD(5); SBAR(); GAPA(C1=__builtin_amdgcn_mfma_f32_32x32x16_bf16(kf[3],qr[1],C1,0,0,0),   P0[14],P0[15],P1[0],P1[1],   pw1[2]=PKW(P0,12),pw1[3]=PKW(P0,14), pw1); \
    VRD(2); SBAR(); GAPA(C0=__builtin_amdgcn_mfma_f32_32x32x16_bf16(kf[4],qr[2],C0,0,0,0),   P1[2],P1[3],P1[4],P1[5],     pw2[0]=PKW(P1,0), pw2[1]=PKW(P1,2), pw2); \
    VRD(6); SBAR(); GAPA(C1=__builtin_amdgcn_mfma_f32_32x32x16_bf16(kf[5],qr[2],C1,0,0,0),   P1[6],P1[7],P1[8],P1[9],     pw2[2]=PKW(P1,4), pw2[3]=PKW(P1,6), pw2); \
    VRD(3); SBAR(); GAPA(C0=__builtin_amdgcn_mfma_f32_32x32x16_bf16(kf[6],qr[3],C0,0,0,0),   P1[10],P1[11],P1[12],P1[13], pw3[0]=PKW(P1,8), pw3[1]=PKW(P1,10), pw3); \
    VRD(7); SBAR(); GAPA(C1=__builtin_amdgcn_mfma_f32_32x32x16_bf16(kf[7],qr[3],C1,0,0,0),   P1[14],P1[15],0.f,0.f,       pw3[2]=PKW(P1,12),pw3[3]=PKW(P1,14), pw3); \
    l_reg+=sacc; \
    if(GK){DMA_K((t)+3,sl_cur);} if(GV){DMA_V((t)+1,sl_next);} \
    CMASK(C0,C1,t); \
    { float a=MX3(C0[0],C0[1],C1[0]),b=MX3(C0[2],C0[3],C1[1]); a=MX3(a,C1[2],C1[3]); \
      _Pragma("unroll") for(int r=4;r<16;r+=4){a=MX3(a,C0[r],C0[r+1]);b=MX3(b,C0[r+2],C0[r+3]);a=MX3(a,C1[r],C1[r+1]);b=MX3(b,C1[r+2],C1[r+3]);} \
      float rm=__builtin_fmaxf(a,b); { auto rr=__builtin_amdgcn_permlane32_swap(__float_as_uint(rm),__float_as_uint(rm),false,false); rm=__builtin_fmaxf(__uint_as_float(rr[0]),__uint_as_float(rr[1])); } \
      resc=false; \
      if(__builtin_expect(__any(rm>(float)THRL),0)){ const float dl=__builtin_fmaxf(rm,0.f); mhat+=dl; \
        _Pragma("unroll") for(int r=0;r<16;++r){C0[r]-=dl;C1[r]-=dl;} \
        { const float nm_=selc?-mhat:-INFINITY; _Pragma("unroll") for(int r=0;r<16;++r)negm[r]=nm_; } asm volatile("":"+v"(negm)); \
        const float f=__builtin_amdgcn_exp2f(-dl); l_reg*=f; if(hi==0)wsf[r32]=f; resc=true; } } \
    SBAR(); \
    GAPB(o[0]=__builtin_amdgcn_mfma_f32_32x32x16_bf16(PAF(0),VFR(0),o[0],0,0,0), C0,0); \
    GAPB(o[1]=__builtin_amdgcn_mfma_f32_32x32x16_bf16(PAF(0),VFR(4),o[1],0,0,0), C0,4); \
    KRD(GL,0); GAPB(o[0]=__builtin_amdgcn_mfma_f32_32x32x16_bf16(PAF(1),VFR(1),o[0],0,0,0), C0,8); \
    KRD(GL,1); GAPB(o[1]=__builtin_amdgcn_mfma_f32_32x32x16_bf16(PAF(1),VFR(5),o[1],0,0,0), C0,12); \
    KRD(GL,2); GAPB(o[0]=__builtin_amdgcn_mfma_f32_32x32x16_bf16(PAF(2),VFR(2),o[0],0,0,0), C1,0); \
    KRD(GL,3); GAPB(o[1]=__builtin_amdgcn_mfma_f32_32x32x16_bf16(PAF(2),VFR(6),o[1],0,0,0), C1,4); \
    GAPB(o[0]=__builtin_amdgcn_mfma_f32_32x32x16_bf16(PAF(3),VFR(3),o[0],0,0,0), C1,8); \
    GAPB(o[1]=__builtin_amdgcn_mfma_f32_32x32x16_bf16(PAF(3),VFR(7),o[1],0,0,0), C1,12); \
    }while(0)
  int t=1;
  #define ENDW(tt) do{ if((tt)+3<NT){WAIT_BAR(2);} else if((tt)+2<NT){WAIT_BAR(1);} else {WAIT_BAR(0);} }while(0)
  #define BLK(tt) do{ if((tt)>=4&&((tt)&3)==0){ selc=((sel>>(((tt)-4)>>2))&1u)!=0u; const float nm_=selc?-mhat:-INFINITY; _Pragma("unroll") for(int r=0;r<16;++r)negm[r]=nm_; asm volatile("":"+v"(negm)); } }while(0)
  for(;t+1<NT;t+=2){
    STEP(pB0,pB1,pA0,pA1,t,(t+3<NT),(t+1<NT),(t+1<NT));       ENDW(t);   RESC(); ROT();
    BLK(t+1);
    STEP(pA0,pA1,pB0,pB1,t+1,(t+4<NT),(t+2<NT),(t+2<NT));     ENDW(t+1); RESC(); ROT();
  }
  STEP(pB0,pB1,pA0,pA1,NT-1,false,false,false); RESC();
  { float sacc=pB0[0]+pB0[1]; _Pragma("unroll") for(int r=2;r<16;++r)sacc+=pB0[r]; _Pragma("unroll") for(int r=0;r<16;++r)sacc+=pB1[r]; l_reg+=sacc;
    pw0=(u32x4){PKW(pB0,0),PKW(pB0,2),PKW(pB0,4),PKW(pB0,6)};pw1=(u32x4){PKW(pB0,8),PKW(pB0,10),PKW(pB0,12),PKW(pB0,14)};pw2=(u32x4){PKW(pB1,0),PKW(pB1,2),PKW(pB1,4),PKW(pB1,6)};pw3=(u32x4){PKW(pB1,8),PKW(pB1,10),PKW(pB1,12),PKW(pB1,14)};
    SBAR(); pv(o,vb0+sl_cur,PAF(0),PAF(1),PAF(2),PAF(3)); }
  #undef PKW
  #undef PAF
  #undef VFR
  #undef PIN
  #undef MX3
  #undef GAPA
  #undef GAPB
  #undef EX
  #undef VRD
  #undef KRD
  #undef STEP
  #undef ENDW
  #undef BLK
  {auto rr=__builtin_amdgcn_permlane32_swap(__float_as_uint(l_reg),__float_as_uint(l_reg),false,false);l_reg=__uint_as_float(rr[0])+__uint_as_float(rr[1]);}
  if(hi==0)wsf[32+r32]=l_reg;asm volatile("s_waitcnt lgkmcnt(0)":::"memory");
  float rli[16];
  #pragma unroll
  for(int r=0;r<16;++r)rli[r]=__builtin_amdgcn_rcpf(wsf[32+crow(r,hi)]);
  bf16*Ow=O+(rowbase+q0+wid*QBLK)*OP+OCOL+h*D;
  { bf16*stg=(bf16*)(shm+LDS_OST)+wid*2048;
    #pragma unroll
    for(int r=0;r<16;++r){const int orow=crow(r,hi);
      #pragma unroll
      for(int d0=0;d0<2;++d0)stg[orow*64+d0*32+r32]=__float2bfloat16(o[d0][r]*rli[r]);}
    asm volatile("s_waitcnt lgkmcnt(0)":::"memory");
    #pragma unroll
    for(int i=0;i<4;++i){const int row=i*8+(lane>>3),ch=lane&7; const u32x4 v=*(const u32x4*)(stg+row*64+ch*8); ATTN_STORE16(Ow+(long)row*OP+ch*8,v);} }
  asm volatile("s_waitcnt lgkmcnt(0)\n\ts_barrier":::"memory");
  #undef DMA_K
  #undef TMAP
  #undef DMA_V
  #undef CMASK
  #undef START
  #undef RESC
  #undef ROT
}
constexpr int ATTN_LDS_BYTES=LDS_BYTES;
#undef SBAR
#undef WAIT_BAR
}

constexpr int DM = 1024, SEQ = 2048, NBAT = 8, MP = NBAT * SEQ;
constexpr int MS = 128, DBAT = 32, DSEQ = 4, NPAGES = 64;
constexpr int NIN = 2560, FF = 4096, DPLE = 256;
constexpr float EPS = 1e-6f;
constexpr float C2 = 0.125f * 1.4426950408889634f;
constexpr size_t O_YP = 0, O_YS = 16777216, O_KP = 16908288, O_VP = 25296896, O_KS = 33685504, O_VS = 33751040, O_AV = 33816576, O_END = 33882112;
constexpr size_t MiB = 1u << 20;
constexpr size_t WS_CTL = 0, CTL_ZERO_BYTES = 1 * MiB;
constexpr size_t WS_WIN = 2 * MiB, WS_WOUT = 8 * MiB, WS_WUP = 10 * MiB, WS_WDN = 18 * MiB, WS_WPG = 26 * MiB, WS_WPP = 28 * MiB, WS_WTRIL = 29 * MiB;
constexpr size_t WS_KMP = 30 * MiB, WS_KMS = 31 * MiB, WS_SS2 = 34 * MiB, WS_SS3 = 35 * MiB, WS_SSE = 36 * MiB;
constexpr size_t WS_XNS = 40 * MiB, WS_PBS = 41 * MiB, WS_US = 42 * MiB, WS_VAS = 43 * MiB, WS_QS = 44 * MiB, WS_MIXS = 45 * MiB, WS_H1BS = 46 * MiB, WS_HBS = 47 * MiB, WS_H2BS = 48 * MiB, WS_ERS = 49 * MiB,
                 WS_SS2S = 50 * MiB, WS_SS3S = 51 * MiB;
constexpr size_t WS_XN = 64 * MiB, WS_PB = 96 * MiB, WS_U = 104 * MiB, WS_VA = 120 * MiB, WS_Q = 136 * MiB, WS_K = 152 * MiB, WS_V = 168 * MiB, WS_MIX = 184 * MiB, WS_H1B = 216 * MiB, WS_H2B = 248 * MiB,
                 WS_ER = 280 * MiB, WS_HB = 312 * MiB, WS_END = 440 * MiB;
constexpr int CW_BAR = 4096;
constexpr int SCR_BYTES = 139264;
constexpr int RS0_OFF = SCR_BYTES, RS1_OFF = RS0_OFF + 1024, MISC_OFF = RS1_OFF + 1024;
constexpr int LDS_BYTES = 147456;
constexpr int NWAVES = 8, NTHR = 512;
static_assert(MISC_OFF + 256 <= LDS_BYTES, "LDS map");

struct Args { const float* in[22]; float* out; unsigned char* ws; int ph_lo, ph_hi; };
enum { I_XP = 0, I_XS, I_PP, I_PS, I_CK, I_CV, I_PT, I_LN1, I_WIN, I_AVN, I_AWS, I_ABS, I_QN, I_KN, I_WOUT, I_LN2, I_WUP, I_WDN, I_LN3, I_WPG, I_WPP, I_PLN };

__device__ __forceinline__ int perm_in(int L) { return (L & ~255) | (((L >> 5) & 1) << 7) | (((L >> 6) & 3) << 5) | (L & 31); }
__device__ __forceinline__ float wave_sum(float v) {
#pragma unroll
    for (int o = 1; o < 64; o <<= 1) v += __shfl_xor(v, o);
    return v;
}
__device__ __forceinline__ float wave_max(float v) {
#pragma unroll
    for (int o = 1; o < 64; o <<= 1) v = fmaxf(v, __shfl_xor(v, o));
    return v;
}
__device__ __forceinline__ float bfu(unsigned short h) { return __uint_as_float((unsigned)h << 16); }

__device__ __forceinline__ void transpose_item(const float* W, int K, int N, bf16* WT, int out_row0, const float* kscale, LAS float* scr, int k0, int n0, int lane) {
#pragma unroll 8
    for (int i = 0; i < 32; ++i) { const int kk = 2 * i + (lane >> 5); float v = W[(size_t)(k0 + kk) * N + n0 + (lane & 31)]; if (kscale) v *= kscale[k0 + kk]; scr[kk * 33 + (lane & 31)] = v; }
    LDS_WAIT(); asm volatile("" ::: "memory");
    const int c = lane & 7;
#pragma unroll
    for (int j = 0; j < 4; ++j) { const int n = (lane >> 3) + 8 * j; const LAS float* s = scr + (8 * c) * 33 + n;
        v4u o; o.x = pk2(s[0 * 33], s[1 * 33]); o.y = pk2(s[2 * 33], s[3 * 33]); o.z = pk2(s[4 * 33], s[5 * 33]); o.w = pk2(s[6 * 33], s[7 * 33]);
        *(v4u*)(WT + (size_t)(out_row0 + n) * K + k0 + 8 * c) = o; }
    LDS_WAIT(); asm volatile("" ::: "memory");
}
__device__ __forceinline__ void rms_row_to_bf16(const float* xrow, const float* gain, bf16* orow, int lane) {
    const f32x4* xr = (const f32x4*)xrow + lane; const f32x4* gr = (const f32x4*)gain + lane;
    f32x4 v[4]; float s = 0.f;
#pragma unroll
    for (int j = 0; j < 4; ++j) { v[j] = xr[64 * j]; s += (v[j].x * v[j].x + v[j].y * v[j].y) + (v[j].z * v[j].z + v[j].w * v[j].w); }
    const float rstd = 1.0f / sqrtf(wave_sum(s) * (1.0f / 1024.0f) + EPS);
    unsigned long long* o8 = (unsigned long long*)orow + lane;
#pragma unroll
    for (int j = 0; j < 4; ++j) { const f32x4 g = gr[64 * j]; o8[64 * j] = (unsigned long long)pk2(v[j].x * rstd * g.x, v[j].y * rstd * g.y) | ((unsigned long long)pk2(v[j].z * rstd * g.z, v[j].w * rstd * g.w) << 32); }
}

template <bool PERMUTED, class Epi>
__device__ __forceinline__ void thin_unit(LAS unsigned char* lds, const bf16* A, int lda, const bf16* Bt, int ldb, int K, int rh, int ct, const Epi& epi) {
    const int tid = threadIdx.x, lane = tid & 63, w = __builtin_amdgcn_readfirstlane(tid >> 6), fr = lane & 15, fq = lane >> 4;
    const int ks = K >> 3, kbeg = w * ks;
    f32x4 acc[4][4];
#pragma unroll
    for (int nt = 0; nt < 4; ++nt)
#pragma unroll
        for (int mt = 0; mt < 4; ++mt) acc[nt][mt] = (f32x4){0.f, 0.f, 0.f, 0.f};
    const bf16* ap = A + (size_t)(rh * 64 + fr) * lda + kbeg + 8 * fq;
    const bf16* bp[4];
#pragma unroll
    for (int nt = 0; nt < 4; ++nt) { const int L = 64 * ct + 16 * nt; const int p = PERMUTED ? perm_in(L) : L; bp[nt] = Bt + (size_t)(p + fr) * ldb + kbeg + 8 * fq; }
#pragma unroll 2
    for (int k = 0; k < ks; k += 32) {
        bf16x8 a[4], b[4];
#pragma unroll
        for (int mt = 0; mt < 4; ++mt) a[mt] = *(const bf16x8*)(ap + (size_t)mt * 16 * lda + k);
#pragma unroll
        for (int nt = 0; nt < 4; ++nt) b[nt] = *(const bf16x8*)(bp[nt] + k);
#pragma unroll
        for (int nt = 0; nt < 4; ++nt)
#pragma unroll
            for (int mt = 0; mt < 4; ++mt) acc[nt][mt] = __builtin_amdgcn_mfma_f32_16x16x32_bf16(b[nt], a[mt], acc[nt][mt], 0, 0, 0);
    }
    LAS float* red = (LAS float*)lds;
#pragma unroll
    for (int nt = 0; nt < 4; ++nt)
#pragma unroll
        for (int mt = 0; mt < 4; ++mt) *(LAS f32x4*)(red + w * (64 * 68) + (16 * mt + fr) * 68 + 16 * nt + 4 * fq) = acc[nt][mt];
    __syncthreads();
    const int row = tid >> 3, cg = tid & 7;
    float v[8];
#pragma unroll
    for (int e = 0; e < 8; ++e) v[e] = 0.f;
#pragma unroll
    for (int ww = 0; ww < 8; ++ww) { const f32x4 x0 = *(const LAS f32x4*)(red + ww * (64 * 68) + row * 68 + 8 * cg), x1 = *(const LAS f32x4*)(red + ww * (64 * 68) + row * 68 + 8 * cg + 4);
#pragma unroll
        for (int e = 0; e < 4; ++e) { v[e] += x0[e]; v[4 + e] += x1[e]; } }
    epi(rh * 64 + row, ct, cg, v);
    __syncthreads();
}
__device__ __forceinline__ void st_bf8(bf16* p, const float (&v)[8]) { v4u o; o.x = pk2(v[0], v[1]); o.y = pk2(v[2], v[3]); o.z = pk2(v[4], v[5]); o.w = pk2(v[6], v[7]); *(v4u*)p = o; }
__device__ __forceinline__ void st_f8(float* p, const float (&v)[8]) { *(f32x4*)p = (f32x4){v[0], v[1], v[2], v[3]}; *(f32x4*)(p + 4) = (f32x4){v[4], v[5], v[6], v[7]}; }
__device__ __forceinline__ float sum8sq(const float (&v)[8]) { float s = 0.f;
#pragma unroll
    for (int e = 0; e < 8; ++e) s += v[e] * v[e]; return s; }
__device__ __forceinline__ float red8(float s) { s += __shfl_xor(s, 1); s += __shfl_xor(s, 2); s += __shfl_xor(s, 4); return s; }

__device__ __forceinline__ void gate_prompt_unit(LAS unsigned char* lds, const bf16* VA, const bf16* U, const bf16* WTRIL, const float* avn, const float* abs_, bf16* MIX, int b, int c, int g) {
    const int tid = threadIdx.x, lane = tid & 63, wv = __builtin_amdgcn_readfirstlane(tid >> 6), fr = lane & 15, fq = lane >> 4;
    const size_t tok0 = (size_t)b * SEQ + (size_t)c * 128;
    LAS bf16* VT = (LAS bf16*)lds;
    { const int r = tid >> 2, qd = tid & 3; const bf16* src = VA + (tok0 + r) * 512 + g * 128 + 32 * qd;
      v4u x[4]; float ss = 0.f;
#pragma unroll
      for (int i = 0; i < 4; ++i) x[i] = *(const v4u*)(src + 8 * i);
      float f[32];
#pragma unroll
      for (int i = 0; i < 4; ++i) { f[8 * i + 0] = __uint_as_float(x[i].x << 16); f[8 * i + 1] = __uint_as_float(x[i].x & 0xffff0000u); f[8 * i + 2] = __uint_as_float(x[i].y << 16); f[8 * i + 3] = __uint_as_float(x[i].y & 0xffff0000u);
          f[8 * i + 4] = __uint_as_float(x[i].z << 16); f[8 * i + 5] = __uint_as_float(x[i].z & 0xffff0000u); f[8 * i + 6] = __uint_as_float(x[i].w << 16); f[8 * i + 7] = __uint_as_float(x[i].w & 0xffff0000u); }
#pragma unroll
      for (int i = 0; i < 32; ++i) ss += f[i] * f[i];
      ss += __shfl_xor(ss, 1); ss += __shfl_xor(ss, 2);
      const float rstd = 1.0f / sqrtf(ss * (1.0f / 128.0f) + EPS);
#pragma unroll
      for (int i = 0; i < 32; ++i) { const int w = 32 * qd + i; VT[w * 136 + r] = (bf16)f2bf(f[i] * rstd * avn[g * 128 + w]); }
    }
    __syncthreads();
    f32x4 acc[8];
#pragma unroll
    for (int wt = 0; wt < 8; ++wt) acc[wt] = (f32x4){0.f, 0.f, 0.f, 0.f};
#pragma unroll
    for (int ks = 0; ks < 4; ++ks) {
        if (32 * ks <= 16 * wv + 15) {
            const bf16x8 bw = *(const bf16x8*)(WTRIL + ((size_t)g * 128 + 16 * wv + fr) * 128 + 32 * ks + 8 * fq);
#pragma unroll
            for (int wt = 0; wt < 8; ++wt) { const bf16x8 av = *(const LAS bf16x8*)(VT + (16 * wt + fr) * 136 + 32 * ks + 8 * fq);
                acc[wt] = __builtin_amdgcn_mfma_f32_16x16x32_bf16(av, bw, acc[wt], 0, 0, 0); }
        }
    }
    { const int t = 16 * wv + fr; const size_t tok = tok0 + t; const float bias = abs_[g * 128 + t];
#pragma unroll
      for (int wt = 0; wt < 8; ++wt) { const int w0 = 16 * wt + 4 * fq; const u32x2 uw = *(const u32x2*)(U + tok * 512 + g * 128 + w0); const f32x4 uf = pg8::bf4_to_f32(uw);
          u32x2 o; o.x = pk2(uf[0] * (acc[wt][0] + bias), uf[1] * (acc[wt][1] + bias)); o.y = pk2(uf[2] * (acc[wt][2] + bias), uf[3] * (acc[wt][3] + bias));
          *(u32x2*)(MIX + tok * 1024 + g * 128 + w0) = o; } }
    __syncthreads();
}
__device__ __forceinline__ void gate_sample_unit(LAS unsigned char* lds, const float* VAS, const float* US, const float* aws, const float* avn, const float* abs_, bf16* MIXS, float* av_out, int b) {
    const int tid = threadIdx.x, lane = tid & 63, wv = tid >> 6, g = tid >> 7;
    LAS float* red = (LAS float*)lds;
    float v[4], ss[4];
#pragma unroll
    for (int s = 0; s < 4; ++s) { v[s] = VAS[(size_t)(4 * b + s) * 512 + tid]; ss[s] = wave_sum(v[s] * v[s]); }
    if (lane == 0) {
#pragma unroll
        for (int s = 0; s < 4; ++s) red[wv * 4 + s] = ss[s]; }
    __syncthreads();
    const float gain = avn[tid];
#pragma unroll
    for (int s = 0; s < 4; ++s) { const float tot = red[(2 * g) * 4 + s] + red[(2 * g + 1) * 4 + s]; v[s] = v[s] * (1.0f / sqrtf(tot * (1.0f / 128.0f) + EPS)) * gain; av_out[(size_t)(4 * b + s) * 512 + tid] = v[s]; }
#pragma unroll
    for (int t = 0; t < 4; ++t) { float sg = abs_[g * 128 + t];
#pragma unroll
        for (int s = 0; s < 4; ++s) if (s <= t) sg += aws[((size_t)g * 128 + t) * 128 + s] * v[s];
        MIXS[(size_t)(4 * b + t) * 1024 + tid] = (bf16)f2bf(US[(size_t)(4 * b + t) * 512 + tid] * sg); }
    __syncthreads();
}
__device__ __forceinline__ void moba_prompt_simple(LAS unsigned char* lds, const bf16* Q, const bf16* K, const bf16* V, const float* KMP, bf16* MIX, int b, int hp, int qb) {
    const int tid = threadIdx.x, hl = tid >> 8, qi = tid & 255, h = 2 * hp + hl;
    const size_t row = (size_t)b * SEQ + (size_t)qb * 256 + qi;
    LAS float* km = (LAS float*)lds;
    LAS bf16* kt = (LAS bf16*)(lds + 4096);
    LAS bf16* vt = (LAS bf16*)(lds + 4096 + 16384);
    float q[64];
    { const v4u* qp = (const v4u*)(Q + row * 512 + h * 64);
#pragma unroll
      for (int i = 0; i < 8; ++i) { const v4u x = qp[i]; q[8 * i + 0] = __uint_as_float(x.x << 16); q[8 * i + 1] = __uint_as_float(x.x & 0xffff0000u); q[8 * i + 2] = __uint_as_float(x.y << 16); q[8 * i + 3] = __uint_as_float(x.y & 0xffff0000u);
          q[8 * i + 4] = __uint_as_float(x.z << 16); q[8 * i + 5] = __uint_as_float(x.z & 0xffff0000u); q[8 * i + 6] = __uint_as_float(x.w << 16); q[8 * i + 7] = __uint_as_float(x.w & 0xffff0000u); } }
    for (int idx = tid; idx < 1024; idx += NTHR) { const int hh = idx >> 9, j = (idx >> 6) & 7, d = idx & 63; float val = 0.f;
        if (j < qb) { const int pm = b * 8 + j, col = (2 * hp + hh) * 64 + d; val = (KMP[(size_t)(pm * 2) * 512 + col] + KMP[(size_t)(pm * 2 + 1) * 512 + col]) * (1.0f / 256.0f); }
        km[idx] = val; }
    __syncthreads();
    unsigned sel = 0;
    { float gsc[8];
#pragma unroll
      for (int j = 0; j < 8; ++j) { float s = 0.f;
#pragma unroll
          for (int d = 0; d < 64; ++d) s += q[d] * km[(hl * 8 + j) * 64 + d];
          gsc[j] = s; }
#pragma unroll
      for (int j = 0; j < 8; ++j) { int rank = 0;
#pragma unroll
          for (int i = 0; i < 8; ++i) if (i != j && i < qb && (gsc[i] > gsc[j] || (gsc[i] == gsc[j] && i < j))) ++rank;
          if (j < qb && rank < 3) sel |= 1u << j; } }
    float o[64], m = 0.f, l = 0.f; bool first = true;
#pragma unroll
    for (int d = 0; d < 64; ++d) o[d] = 0.f;
    for (int kb = 0; kb <= qb; ++kb)
        for (int t = 0; t < 4; ++t) {
            __syncthreads();
            { const size_t krow0 = (size_t)b * SEQ + (size_t)kb * 256 + t * 64;
#pragma unroll
              for (int i = 0; i < 2; ++i) { const int ch = tid + i * NTHR, r = ch >> 4, cc = ch & 15;
                  *(LAS v4u*)(kt + r * 128 + cc * 8) = *(const v4u*)(K + (krow0 + r) * 512 + hp * 128 + cc * 8);
                  *(LAS v4u*)(vt + r * 128 + cc * 8) = *(const v4u*)(V + (krow0 + r) * 512 + hp * 128 + cc * 8); } }
            __syncthreads();
            const bool own = (kb == qb);
            const bool act = own ? (t * 64 <= qi) : (((sel >> kb) & 1u) != 0u);
            if (act) {
                const int nk = own ? min(64, qi - t * 64 + 1) : 64;
                for (int kk = 0; kk < nk; ++kk) {
                    float s = 0.f;
#pragma unroll
                    for (int i = 0; i < 8; ++i) { const v4u x = *(const LAS v4u*)(kt + kk * 128 + hl * 64 + 8 * i);
                        s += q[8 * i + 0] * __uint_as_float(x.x << 16) + q[8 * i + 1] * __uint_as_float(x.x & 0xffff0000u) + q[8 * i + 2] * __uint_as_float(x.y << 16) + q[8 * i + 3] * __uint_as_float(x.y & 0xffff0000u)
                           + q[8 * i + 4] * __uint_as_float(x.z << 16) + q[8 * i + 5] * __uint_as_float(x.z & 0xffff0000u) + q[8 * i + 6] * __uint_as_float(x.w << 16) + q[8 * i + 7] * __uint_as_float(x.w & 0xffff0000u); }
                    if (first) { m = s; first = false; }
                    if (s > m + 8.0f) { const float f = __builtin_amdgcn_exp2f(m - s); l *= f;
#pragma unroll
                        for (int d = 0; d < 64; ++d) o[d] *= f;
                        m = s; }
                    const float p = __builtin_amdgcn_exp2f(s - m); l += p;
#pragma unroll
                    for (int i = 0; i < 8; ++i) { const v4u x = *(const LAS v4u*)(vt + kk * 128 + hl * 64 + 8 * i);
                        o[8 * i + 0] += p * __uint_as_float(x.x << 16); o[8 * i + 1] += p * __uint_as_float(x.x & 0xffff0000u); o[8 * i + 2] += p * __uint_as_float(x.y << 16); o[8 * i + 3] += p * __uint_as_float(x.y & 0xffff0000u);
                        o[8 * i + 4] += p * __uint_as_float(x.z << 16); o[8 * i + 5] += p * __uint_as_float(x.z & 0xffff0000u); o[8 * i + 6] += p * __uint_as_float(x.w << 16); o[8 * i + 7] += p * __uint_as_float(x.w & 0xffff0000u); }
                }
            }
        }
    { const float rl = 1.0f / l; bf16* op = MIX + row * 1024 + 512 + h * 64;
#pragma unroll
      for (int i = 0; i < 8; ++i) { v4u w; w.x = pk2(o[8 * i] * rl, o[8 * i + 1] * rl); w.y = pk2(o[8 * i + 2] * rl, o[8 * i + 3] * rl); w.z = pk2(o[8 * i + 4] * rl, o[8 * i + 5] * rl); w.w = pk2(o[8 * i + 6] * rl, o[8 * i + 7] * rl); *(v4u*)(op + 8 * i) = w; } }
    __syncthreads();
}
__device__ __forceinline__ void moba_sample_unit(LAS unsigned char* lds, const float* QS, const float* ksn, const float* vsn, const float* ck, const float* cv, const int* pt, const float* KMS, bf16* MIXS, int b, int h, int i) {
    const int tid = threadIdx.x, lane = tid & 63, wv = __builtin_amdgcn_readfirstlane(tid >> 6), c = lane & 15, kq = lane >> 4;
    LAS float* gl = (LAS float*)lds;
    LAS int* sel = (LAS int*)(lds + 128);
    LAS float* sc = (LAS float*)(lds + 256);
    LAS float* redw = (LAS float*)(lds + 256 + 3200);
    LAS float* redv = (LAS float*)(lds + 4096);
    const float* qrow = QS + (size_t)(4 * b + i) * 512 + h * 64;
    const f32x4 q4 = *(const f32x4*)(qrow + 4 * c);
    if (tid < 32) { const float* kmrow = KMS + ((size_t)b * 32 + tid) * 512 + h * 64; float s = 0.f;
#pragma unroll
        for (int d = 0; d < 16; ++d) s += pg8::dot4(*(const f32x4*)(qrow + 4 * d), *(const f32x4*)(kmrow + 4 * d));
        gl[tid] = s; }
    __syncthreads();
    if (tid == 0) { unsigned taken = 0;
        for (int r = 0; r < 3; ++r) { int best = -1; float bv = 0.f;
            for (int j = 0; j < 32; ++j) { if ((taken >> j) & 1u) continue; const float gj = gl[j]; if (best < 0 || gj > bv) { best = j; bv = gj; } }
            taken |= 1u << best; sel[r] = best; } }
    __syncthreads();
    const int s0 = sel[0], s1 = sel[1], s2 = sel[2];
    for (int it = 0; it < 24; ++it) { const int kk = 96 * wv + 4 * it + kq, slot = kk >> 8, pos = kk & 255; const int j = slot == 0 ? s0 : (slot == 1 ? s1 : s2);
        const int page = pt[b * NPAGES + 2 * j + (pos >> 7)];
        const f32x4 k4 = *(const f32x4*)(ck + ((size_t)page * 128 + (pos & 127)) * 512 + h * 64 + 4 * c);
        float d = pg8::dot4(q4, k4); d += __shfl_xor(d, 1); d += __shfl_xor(d, 2); d += __shfl_xor(d, 4); d += __shfl_xor(d, 8);
        if (c == 0) sc[kk] = d * 0.125f; }
    if (wv == 0 && kq <= i) { const f32x4 k4 = *(const f32x4*)(ksn + (size_t)(4 * b + kq) * 512 + h * 64 + 4 * c);
        float d = pg8::dot4(q4, k4); d += __shfl_xor(d, 1); d += __shfl_xor(d, 2); d += __shfl_xor(d, 4); d += __shfl_xor(d, 8);
        if (c == 0) sc[768 + kq] = d * 0.125f; }
    __syncthreads();
    const int n = 768 + i + 1;
    float mx = -INFINITY;
    for (int k = tid; k < n; k += NTHR) mx = fmaxf(mx, sc[k]);
    mx = wave_max(mx); if (lane == 0) redw[wv] = mx;
    __syncthreads();
    mx = redw[0];
#pragma unroll
    for (int w2 = 1; w2 < 8; ++w2) mx = fmaxf(mx, redw[w2]);
    float sm = 0.f;
    for (int k = tid; k < n; k += NTHR) { const float p = __builtin_amdgcn_exp2f((sc[k] - mx) * 1.4426950408889634f); sc[k] = p; sm += p; }
    sm = wave_sum(sm); if (lane == 0) redw[8 + wv] = sm;
    __syncthreads();
    sm = 0.f;
#pragma unroll
    for (int w2 = 0; w2 < 8; ++w2) sm += redw[8 + w2];
    f32x4 a4 = (f32x4){0.f, 0.f, 0.f, 0.f};
    for (int it = 0; it < 24; ++it) { const int kk = 96 * wv + 4 * it + kq, slot = kk >> 8, pos = kk & 255; const int j = slot == 0 ? s0 : (slot == 1 ? s1 : s2);
        const int page = pt[b * NPAGES + 2 * j + (pos >> 7)];
        const f32x4 v4 = *(const f32x4*)(cv + ((size_t)page * 128 + (pos & 127)) * 512 + h * 64 + 4 * c);
        a4 += v4 * sc[kk]; }
    if (wv == 0 && kq <= i) { const f32x4 v4 = *(const f32x4*)(vsn + (size_t)(4 * b + kq) * 512 + h * 64 + 4 * c); a4 += v4 * sc[768 + kq]; }
#pragma unroll
    for (int e = 0; e < 4; ++e) { float x = a4[e]; x += __shfl_xor(x, 16); x += __shfl_xor(x, 32); a4[e] = x; }
    if (kq == 0) *(LAS f32x4*)(redv + wv * 64 + 4 * c) = a4;
    __syncthreads();
    if (tid < 64) { float s = 0.f;
#pragma unroll
        for (int w2 = 0; w2 < 8; ++w2) s += redv[w2 * 64 + tid];
        MIXS[(size_t)(4 * b + i) * 1024 + 512 + h * 64 + tid] = (bf16)f2bf(s / sm); }
    __syncthreads();
}
struct EOrder {
    int c, nu;
    __device__ __forceinline__ bool next(int i, pg8::Unit& u) const { if (c < 128 || i >= nu) return false; u.pm = 8 * (c % 8) + (c / 8) % 8; u.pn = 2 * (c / 64 - 2) + i; return true; }
    __device__ __forceinline__ void a_ready(const pg8::Unit&) const {}
    __device__ __forceinline__ void done(const pg8::Unit&) const {}
};

#ifndef MK_N_LAUNCHES
#define MK_N_LAUNCHES 1
#endif
constexpr int N_PHASES = 7;

__global__ void __launch_bounds__(NTHR, 2) fwd(Args args) {
    extern __shared__ __attribute__((aligned(16))) unsigned char lds_raw[];
    LAS unsigned char* lds = (LAS unsigned char*)lds_raw;
    volatile LAS unsigned* MISC = (volatile LAS unsigned*)(lds + MISC_OFF);
    const int tid = threadIdx.x, lane = tid & 63, wave = __builtin_amdgcn_readfirstlane(tid >> 6);
    const int G = gridDim.x, bx = blockIdx.x, vcu = (G % 8 == 0) ? (bx % 8) * (G / 8) + bx / 8 : bx;
    unsigned char* ws = args.ws;
    unsigned* ctl = (unsigned*)(ws + WS_CTL);
    float* out = args.out;
    for (int u = tid; u < (LDS_BYTES - SCR_BYTES) / 4; u += NTHR) ((LAS unsigned*)(lds + SCR_BYTES))[u] = 0u;
    __syncthreads();
    XcdBarrier bar; bar.bar = ctl + CW_BAR; bar.x = 0; bar.st = nullptr;
    if (MK_N_LAUNCHES == 1) bar = xcd_barrier_post(ctl + CW_BAR, MISC + 8);
#define GRID_BAR() do { if (MK_N_LAUNCHES == 1) xcd_barrier(bar); } while (0)
    const int lo = args.ph_lo, hi = args.ph_hi;
#ifndef PH_MASK
#define PH_MASK 0x7f
#endif
#define IN(k) (((PH_MASK >> (k)) & 1) && lo <= (k) && (k) < hi)
#define BOTH(k) (IN(k) && IN((k) + 1))
    bf16* WIN = (bf16*)(ws + WS_WIN); bf16* WOUT = (bf16*)(ws + WS_WOUT); bf16* WUP = (bf16*)(ws + WS_WUP); bf16* WDN = (bf16*)(ws + WS_WDN); bf16* WPG = (bf16*)(ws + WS_WPG); bf16* WPP = (bf16*)(ws + WS_WPP);
    bf16* WTRIL = (bf16*)(ws + WS_WTRIL);
    float* KMP = (float*)(ws + WS_KMP); float* KMS = (float*)(ws + WS_KMS); float* SS2 = (float*)(ws + WS_SS2); float* SS3 = (float*)(ws + WS_SS3); float* SSE = (float*)(ws + WS_SSE);
    bf16* XNS = (bf16*)(ws + WS_XNS); bf16* PBS = (bf16*)(ws + WS_PBS); float* US = (float*)(ws + WS_US); float* VAS = (float*)(ws + WS_VAS); float* QS = (float*)(ws + WS_QS);
    bf16* MIXS = (bf16*)(ws + WS_MIXS); bf16* H1BS = (bf16*)(ws + WS_H1BS); bf16* HBS = (bf16*)(ws + WS_HBS); bf16* H2BS = (bf16*)(ws + WS_H2BS); float* ERS = (float*)(ws + WS_ERS);
    float* SS2S = (float*)(ws + WS_SS2S); float* SS3S = (float*)(ws + WS_SS3S);
    bf16* XN = (bf16*)(ws + WS_XN); bf16* PB = (bf16*)(ws + WS_PB); bf16* U = (bf16*)(ws + WS_U); bf16* VA = (bf16*)(ws + WS_VA); bf16* Q = (bf16*)(ws + WS_Q); bf16* K = (bf16*)(ws + WS_K); bf16* V = (bf16*)(ws + WS_V);
    bf16* MIX = (bf16*)(ws + WS_MIX); bf16* H1B = (bf16*)(ws + WS_H1B); bf16* H2B = (bf16*)(ws + WS_H2B); bf16* ER = (bf16*)(ws + WS_ER); bf16* HB = (bf16*)(ws + WS_HB);
    LAS float* RS0 = (LAS float*)(lds + RS0_OFF); LAS float* RS1 = (LAS float*)(lds + RS1_OFF);
    const int gw = vcu * NWAVES + wave, NGW = G * NWAVES;
    const int my_pm = 8 * (bx % 8) + (bx / 8) % 8;

    if (IN(0)) {
        LAS float* scr = (LAS float*)(lds + wave * 16384);
        constexpr int T_IN = 16 * 80, T_OUT = 16 * 32, T_UP = 16 * 128, T_DN = 64 * 32, T_PG = 16 * 32, T_PP = 4 * 32, NITEMS = T_IN + T_OUT + T_UP + T_DN + T_PG + T_PP;
        for (int it = gw; it < NITEMS; it += NGW) {
            int r = it;
            if (r < T_IN) { const int kb = r / 80, nb = r % 80; transpose_item(args.in[I_WIN], DM, NIN, WIN, perm_in(32 * nb), nullptr, scr, 64 * kb, 32 * nb, lane); continue; } r -= T_IN;
            if (r < T_OUT) { const int kb = r / 32, nb = r % 32; transpose_item(args.in[I_WOUT], DM, DM, WOUT, 32 * nb, nullptr, scr, 64 * kb, 32 * nb, lane); continue; } r -= T_OUT;
            if (r < T_UP) { const int kb = r / 128, nb = r % 128; transpose_item(args.in[I_WUP], DM, FF, WUP, 32 * nb, args.in[I_LN2], scr, 64 * kb, 32 * nb, lane); continue; } r -= T_UP;
            if (r < T_DN) { const int kb = r / 32, nb = r % 32; transpose_item(args.in[I_WDN], FF, DM, WDN, 32 * nb, nullptr, scr, 64 * kb, 32 * nb, lane); continue; } r -= T_DN;
            if (r < T_PG) { const int kb = r / 32, nb = r % 32; transpose_item(args.in[I_WPG], DM, DM, WPG, 32 * nb, args.in[I_LN3], scr, 64 * kb, 32 * nb, lane); continue; } r -= T_PG;
            { const int kb = r / 32, nb = r % 32; transpose_item(args.in[I_WPP], DPLE, DM, WPP, 32 * nb, nullptr, scr, 64 * kb, 32 * nb, lane); }
        }
        for (int e = gw * 64 + lane; e < 4 * 128 * 128; e += NGW * 64) { const int t = (e >> 7) & 127, s = e & 127; WTRIL[e] = (bf16)(s <= t ? f2bf(args.in[I_AWS][e]) : 0u); }
        for (int m = gw; m < MP + MS; m += NGW) {
            if (m < MP) rms_row_to_bf16(args.in[I_XP] + (size_t)m * DM, args.in[I_LN1], XN + (size_t)m * DM, lane);
            else rms_row_to_bf16(args.in[I_XS] + (size_t)(m - MP) * DM, args.in[I_LN1], XNS + (size_t)(m - MP) * DM, lane);
        }
        for (int e = gw * 64 + lane; e < (MP + MS) * DPLE / 8; e += NGW * 64) {
            const bool sm = e >= MP * DPLE / 8; const int ee = sm ? e - MP * DPLE / 8 : e;
            const float* src = (sm ? args.in[I_PS] : args.in[I_PP]) + (size_t)ee * 8; bf16* dst = (sm ? PBS : PB) + (size_t)ee * 8;
            const f32x4 a = *(const f32x4*)src, b = *(const f32x4*)(src + 4); v4u o; o.x = pk2(a.x, a.y); o.y = pk2(a.z, a.w); o.z = pk2(b.x, b.y); o.w = pk2(b.z, b.w); *(v4u*)dst = o;
        }
        { const int* pt = (const int*)args.in[I_PT]; const float* ck = args.in[I_CK]; LAS f32x4* red = (LAS f32x4*)lds;
          __syncthreads();
          for (int un = vcu; un < DBAT * 32; un += G) { const int b = un >> 5, j = un & 31; const int p0 = pt[b * NPAGES + 2 * j], p1 = pt[b * NPAGES + 2 * j + 1];
              const int cgp = tid & 127, ph = tid >> 7; f32x4 a = (f32x4){0.f, 0.f, 0.f, 0.f};
#pragma unroll 16
              for (int r = 0; r < 64; ++r) { const int rw = ph + 4 * r; const int page = rw < 128 ? p0 : p1;
                  a += __builtin_nontemporal_load((const f32x4*)(ck + ((size_t)page * 128 + (rw & 127)) * 512 + 4 * cgp)); }
              red[ph * 128 + cgp] = a;
              __syncthreads();
              if (tid < 128) { const f32x4 s = (red[tid] + red[128 + tid]) + (red[256 + tid] + red[384 + tid]); *(f32x4*)(KMS + (size_t)un * 512 + 4 * tid) = s * (1.0f / 256.0f); }
              __syncthreads(); } }
        if (BOTH(0)) GRID_BAR();
    }

    if (IN(1)) {
#ifndef P1M
#define P1M 7
#endif
        if (P1M & 1) { pg8::Gemm g{XN, WIN, MP, NIN, DM}; pg8::StaticOrder S; S.init(MP, NIN, G, bx);
          pg8::EpiIn E{U, VA, Q, K, V, out + O_KP, out + O_VP, KMP, args.in[I_QN], args.in[I_KN], C2, EPS};
          pg8::gemm_phase<pg8::EpiIn, pg8::StaticOrder, true, true>(lds, g, S, E); }
        __syncthreads();
        if (P1M & 2) { int two, kple; asm volatile("s_mov_b32 %0, 2" : "=s"(two)); asm volatile("s_mov_b32 %0, 256" : "=s"(kple)); pg8::Gemm g{PB, WPP, MP, DM, kple};
          EOrder S{bx, two}; pg8::EpiE E{ER, SSE};
          pg8::gemm_phase<pg8::EpiE, EOrder, true, true>(lds, g, S, E); }
        __syncthreads();
        if (P1M & 4) { const float* qn = args.in[I_QN]; const float* kn = args.in[I_KN]; float* kso = out + O_KS; float* vso = out + O_VS;
          auto epi_in = [=](int row, int ct, int cg, float (&v)[8]) __attribute__((always_inline)) {
              const int sec = ct >> 3, cs = (ct & 7) * 64 + 8 * cg;
              if (sec == 0 || sec == 1) {
#pragma unroll
                  for (int e = 0; e < 8; ++e) v[e] = pg8::gelu_t(v[e]);
                  st_f8((float*)(ws + (sec == 0 ? WS_US : WS_VAS)) + (size_t)row * 512 + cs, v);
              } else if (sec == 4) { st_f8(vso + (size_t)row * 512 + cs, v); }
              else { const float ss = red8(sum8sq(v)); const float rstd = 1.0f / sqrtf(ss * (1.0f / 64.0f) + EPS);
                  if (sec == 2) {
#pragma unroll
                      for (int e = 0; e < 8; ++e) v[e] = v[e] * rstd * qn[8 * cg + e];
                      st_f8(QS + (size_t)row * 512 + cs, v);
                  } else {
#pragma unroll
                      for (int e = 0; e < 8; ++e) v[e] = v[e] * rstd * kn[8 * cg + e];
                      st_f8(kso + (size_t)row * 512 + cs, v); } } };
          auto epi_e = [=](int row, int ct, int cg, float (&v)[8]) __attribute__((always_inline)) { st_f8(ERS + (size_t)row * 1024 + 64 * ct + 8 * cg, v); };
          for (int un = G - 1 - bx; un < 80 + 32; un += G) {
              if (un < 80) thin_unit<true>(lds, XNS, DM, WIN, DM, DM, un / 40, un % 40, epi_in);
              else { const int e = un - 80; thin_unit<false>(lds, PBS, DPLE, WPP, DPLE, DPLE, e / 16, e % 16, epi_e); } } }
        if (BOTH(1)) GRID_BAR();
    }

    if (IN(2)) {
#if defined(MOBA_SIMPLE)
        for (int un = vcu; un < 256; un += G) { const int qb = 7 - (un >> 5), r = un & 31; moba_prompt_simple(lds, Q, K, V, KMP, MIX, r >> 2, r & 3, qb); }
#else
        for (int un = vcu; un < 256; un += G) { const int bh = un >> 2, s4 = un & 3;
#pragma unroll 1
            for (int i2 = 0; i2 < 2; ++i2)
                attn_body::attn_unit<8>(bh >> 3, bh & 7, i2 == 0 ? s4 : 7 - s4, (const attn_body::bf16*)Q, (const attn_body::bf16*)K, (const attn_body::bf16*)V, (attn_body::bf16*)MIX, KMP, (char*)lds_raw); }
        __syncthreads();
#endif
        for (int un = vcu; un < 512; un += G) gate_prompt_unit(lds, VA, U, WTRIL, args.in[I_AVN], args.in[I_ABS], MIX, un >> 6, (un >> 2) & 15, un & 3);
        for (int un = vcu; un < DBAT; un += G) gate_sample_unit(lds, VAS, US, args.in[I_AWS], args.in[I_AVN], args.in[I_ABS], MIXS, out + O_AV, un);
        for (int un = vcu; un < DBAT * 8 * DSEQ; un += G) moba_sample_unit(lds, QS, out + O_KS, out + O_VS, args.in[I_CK], args.in[I_CV], (const int*)args.in[I_PT], KMS, MIXS, un >> 5, (un >> 2) & 7, un & 3);
        if (BOTH(2)) GRID_BAR();
    }

    if (IN(3)) {
        { pg8::Gemm g{MIX, WOUT, MP, DM, DM}; pg8::StaticOrder S; S.init(MP, DM, G, bx); pg8::EpiRes E{args.in[I_XP], out + O_YP, H1B, SS2};
          pg8::gemm_phase<pg8::EpiRes, pg8::StaticOrder, false, true>(lds, g, S, E); }
        __syncthreads();
        { const float* xs = args.in[I_XS]; float* ys = out + O_YS;
          auto epi = [=](int row, int ct, int cg, float (&v)[8]) __attribute__((always_inline)) { const size_t off = (size_t)row * 1024 + 64 * ct + 8 * cg; const f32x4 a = *(const f32x4*)(xs + off), b = *(const f32x4*)(xs + off + 4);
              v[0] += a.x; v[1] += a.y; v[2] += a.z; v[3] += a.w; v[4] += b.x; v[5] += b.y; v[6] += b.z; v[7] += b.w;
              st_f8(ys + off, v); st_bf8(H1BS + off, v); const float ss = red8(sum8sq(v)); if (cg == 0) SS2S[row * 16 + ct] = ss; };
          for (int un = G - 1 - bx; un < 32; un += G) thin_unit<false>(lds, MIXS, DM, WOUT, DM, DM, un / 16, un % 16, epi); }
        if (BOTH(3)) GRID_BAR();
    }

    if (IN(4)) {
        if (tid < 256) { const f32x4 s = *(const f32x4*)(SS2 + (size_t)(my_pm * 256 + tid) * 4); RS0[tid] = 1.0f / sqrtf(((s.x + s.y) + (s.z + s.w)) * (1.0f / 1024.0f) + EPS); }
        __syncthreads();
        { pg8::Gemm g{H1B, WUP, MP, FF, DM}; pg8::StaticOrder S; S.init(MP, FF, G, bx); pg8::EpiUp E{HB, RS0};
          pg8::gemm_phase<pg8::EpiUp, pg8::StaticOrder, true, true>(lds, g, S, E); }
        __syncthreads();
        { auto epi = [=](int row, int ct, int cg, float (&v)[8]) __attribute__((always_inline)) { float s = 0.f;
#pragma unroll
              for (int e = 0; e < 16; ++e) s += SS2S[row * 16 + e];
              const float r = 1.0f / sqrtf(s * (1.0f / 1024.0f) + EPS);
#pragma unroll
              for (int e = 0; e < 8; ++e) { const float a = fmaxf(v[e] * r, 0.f); v[e] = a * a; }
              st_bf8(HBS + (size_t)row * FF + 64 * ct + 8 * cg, v); };
          for (int un = G - 1 - bx; un < 128; un += G) thin_unit<false>(lds, H1BS, DM, WUP, DM, DM, un / 64, un % 64, epi); }
        if (BOTH(4)) GRID_BAR();
    }

    if (IN(5)) {
        { pg8::Gemm g{HB, WDN, MP, DM, FF}; pg8::StaticOrder S; S.init(MP, DM, G, bx); pg8::EpiRes E{out + O_YP, out + O_YP, H2B, SS3};
          pg8::gemm_phase<pg8::EpiRes, pg8::StaticOrder, false, true>(lds, g, S, E); }
        __syncthreads();
        { float* ys = out + O_YS;
          auto epi = [=](int row, int ct, int cg, float (&v)[8]) __attribute__((always_inline)) { const size_t off = (size_t)row * 1024 + 64 * ct + 8 * cg; const f32x4 a = *(const f32x4*)(ys + off), b = *(const f32x4*)(ys + off + 4);
              v[0] += a.x; v[1] += a.y; v[2] += a.z; v[3] += a.w; v[4] += b.x; v[5] += b.y; v[6] += b.z; v[7] += b.w;
              st_f8(ys + off, v); st_bf8(H2BS + off, v); const float ss = red8(sum8sq(v)); if (cg == 0) SS3S[row * 16 + ct] = ss; };
          for (int un = G - 1 - bx; un < 32; un += G) thin_unit<false>(lds, HBS, FF, WDN, FF, FF, un / 16, un % 16, epi); }
        if (BOTH(5)) GRID_BAR();
    }

    if (IN(6)) {
        if (tid < 256) { const size_t row = (size_t)my_pm * 256 + tid; const f32x4 s = *(const f32x4*)(SS3 + row * 4); RS0[tid] = 1.0f / sqrtf(((s.x + s.y) + (s.z + s.w)) * (1.0f / 1024.0f) + EPS);
            float se = 0.f;
#pragma unroll
            for (int e = 0; e < 4; ++e) { const f32x4 t4 = *(const f32x4*)(SSE + row * 16 + 4 * e); se += (t4.x + t4.y) + (t4.z + t4.w); }
            RS1[tid] = 1.0f / sqrtf(se * (1.0f / 1024.0f) + EPS); }
        __syncthreads();
        { pg8::Gemm g{H2B, WPG, MP, DM, DM}; pg8::StaticOrder S; S.init(MP, DM, G, bx); pg8::EpiPle E{out + O_YP, ER, args.in[I_PLN], RS0, RS1};
          pg8::gemm_phase<pg8::EpiPle, pg8::StaticOrder, false, true>(lds, g, S, E); }
        __syncthreads();
        { float* ys = out + O_YS; const float* pln = args.in[I_PLN];
          auto epi = [=](int row, int ct, int cg, float (&v)[8]) __attribute__((always_inline)) { float s = 0.f;
#pragma unroll
              for (int e = 0; e < 16; ++e) s += SS3S[row * 16 + e];
              const float r3 = 1.0f / sqrtf(s * (1.0f / 1024.0f) + EPS);
              float se = 0.f; const float* er = ERS + (size_t)row * 1024;
              for (int e = 0; e < 256; ++e) { const f32x4 t4 = *(const f32x4*)(er + 4 * e); se += (t4.x * t4.x + t4.y * t4.y) + (t4.z * t4.z + t4.w * t4.w); }
              const float re = 1.0f / sqrtf(se * (1.0f / 1024.0f) + EPS);
              const size_t off = (size_t)row * 1024 + 64 * ct + 8 * cg;
#pragma unroll
              for (int e = 0; e < 8; ++e) { const float gt = 1.0f / (1.0f + __expf(-r3 * v[e])); v[e] = ys[off + e] + gt * (er[64 * ct + 8 * cg + e] * re * pln[64 * ct + 8 * cg + e]); }
              st_f8(ys + off, v); };
          for (int un = G - 1 - bx; un < 32; un += G) thin_unit<false>(lds, H2BS, DM, WPG, DM, DM, un / 16, un % 16, epi); }
    }
#undef IN
#undef BOTH
}

extern "C" void kernel_launch(void* const* d_in, const int* in_sizes, int n_in, void* d_out, int out_size, void* d_ws, size_t ws_size, hipStream_t stream) {
    static int grid = 0;
    if (grid == 0) {
        if (n_in != 22 || (size_t)out_size != O_END || ws_size < WS_END) { fprintf(stderr, "kernel_launch: unexpected problem shape (n_in %d, out %d, ws %zu); nothing launched\n", n_in, out_size, ws_size); grid = -1; return; }
        int dev = 0, cus = 0, per_cu = 0;
        if (hipGetDevice(&dev) != hipSuccess || hipDeviceGetAttribute(&cus, hipDeviceAttributeMultiprocessorCount, dev) != hipSuccess) { grid = -1; return; }
        if (hipFuncSetAttribute((const void*)fwd, hipFuncAttributeMaxDynamicSharedMemorySize, LDS_BYTES) != hipSuccess) { fprintf(stderr, "kernel_launch: hipFuncSetAttribute failed\n"); grid = -1; return; }
        if (hipOccupancyMaxActiveBlocksPerMultiprocessor(&per_cu, (const void*)fwd, NTHR, LDS_BYTES) != hipSuccess || per_cu < 1) fprintf(stderr, "kernel_launch: occupancy query reports %d\n", per_cu);
        (void)hipGetLastError();
        grid = cus;
        if (grid != 256) { fprintf(stderr, "kernel_launch: built for 256 CUs, found %d; nothing launched\n", cus); grid = -1; return; }
    }
    if (grid < 0) return;
    if (hipMemsetAsync((char*)d_ws + WS_CTL, 0, CTL_ZERO_BYTES, stream) != hipSuccess) return;
    Args a{};
    for (int i = 0; i < 22; ++i) a.in[i] = (const float*)d_in[i];
    a.out = (float*)d_out; a.ws = (unsigned char*)d_ws;
    for (int li = 0; li < MK_N_LAUNCHES; ++li) {
        a.ph_lo = (MK_N_LAUNCHES == 1) ? 0 : li; a.ph_hi = (MK_N_LAUNCHES == 1) ? N_PHASES : li + 1;
        hipLaunchKernelGGL(fwd, dim3(grid), dim3(NTHR), LDS_BYTES, stream, a);
    }
}
```

```cpp
#include <hip/hip_runtime.h>
#include <cstdio>
#include <cstdint>
namespace pg8 {
#define PG8_LAS __attribute__((address_space(3)))
typedef unsigned short bf16_t;
typedef short bf16x8 __attribute__((ext_vector_type(8)));
typedef float f32x4 __attribute__((ext_vector_type(4)));
typedef unsigned u32x4 __attribute__((ext_vector_type(4)));
constexpr int BM = 256, BK = 64, HALF = 128, HTB = HALF * BK * 2  , STAGE_BYTES = 8 * HTB, NXCD = 8, WGM = 8;

__host__ __device__ __forceinline__ int lds_byte(int r, int c) { const int st = (r >> 4) * 2 + (c >> 5), rr = r & 15, cc = c & 31, ob = rr * 64 + cc * 2; return st * 1024 + (ob ^ (((ob >> 9) & 1) << 5)); }
__host__ __device__ __forceinline__ void stage_rc(int b, int& R, int& C) { const int st = b / 1024, sb = b % 1024, swz = sb ^ (((sb >> 9) & 1) << 5); R = (st >> 1) * 16 + swz / 64; C = (st & 1) * 32 + (swz % 64) / 2; }
__host__ __device__ __forceinline__ int perm32(int rho) { const int n = rho >> 4, i = rho & 15; return 8 * (i >> 2) + 4 * n + (i & 3); }

struct Unit { int pm, pn; };
struct Gemm { const bf16_t* A; const bf16_t* Bt; int M, N, K; };

struct StaticOrder {
    int nM, nN, nwg, G, c;
    __host__ __device__ void init(int M, int N, int G_, int c_) { nM = M / BM; nN = N / BM; nwg = nM * nN; G = G_; c = c_; }
    __host__ __device__ bool next(int i, Unit& u) const {
        const long L = (long)i * G + c; if (L >= nwg) return false;
        int wgid = (int)L; { const int q = nwg / NXCD, r = nwg % NXCD, xcd = wgid % NXCD, off = wgid / NXCD; wgid = (xcd < r ? xcd * (q + 1) : r * (q + 1) + (xcd - r) * q) + off; }
        const int nig = WGM * nN, gid = wgid / nig, fm = gid * WGM, gsz = (nM - fm) < WGM ? (nM - fm) : WGM;
        u.pm = fm + ((wgid % nig) % gsz); u.pn = (wgid % nig) / gsz; return true;
    }
    __device__ __forceinline__ void a_ready(const Unit&) const {}
    __device__ __forceinline__ void done(const Unit&) const {}
};

__device__ __forceinline__ unsigned cvt_pk_bf16(float lo, float hi) { unsigned r; asm volatile("v_cvt_pk_bf16_f32 %0, %1, %2" : "=v"(r) : "v"(lo), "v"(hi)); return r; }
typedef float f32x2 __attribute__((ext_vector_type(2)));
__device__ __forceinline__ f32x2 gelu_pk(f32x2 v) {
    const f32x2 av = __builtin_elementwise_abs(v), d = av * 0.2316418882f + 1.0f;
    f32x2 t; t.x = __builtin_amdgcn_rcpf(d.x); t.y = __builtin_amdgcn_rcpf(d.y);
    f32x2 q = t * 0.5307027145f + (-0.7265760135f); q = q * t + 0.7107068705f; q = q * t + (-0.142248368f); q = q * t + 0.127414796f; q = q * t;
    const f32x2 s = (v * v) * (-0.72134752044f);
    f32x2 e; e.x = __builtin_amdgcn_exp2f(s.x); e.y = __builtin_amdgcn_exp2f(s.y);
    const f32x2 m = v * (q * e), r = v - m;
    f32x2 o; o.x = v.x < 0.f ? m.x : r.x; o.y = v.y < 0.f ? m.y : r.y; return o;
}

typedef float f32x2 __attribute__((ext_vector_type(2)));
typedef unsigned u32x2 __attribute__((ext_vector_type(2)));
__device__ __forceinline__ float gelu_t(float x) {
    const float u = x * (1.5957691216f + 0.0713548163f * x * x);
    const float e = __builtin_amdgcn_exp2f(-1.4426950408889634f * u);
    return x * __builtin_amdgcn_rcpf(1.0f + e);
}
__device__ __forceinline__ f32x4 gelu4(f32x4 v) { return (f32x4){gelu_t(v[0]), gelu_t(v[1]), gelu_t(v[2]), gelu_t(v[3])}; }
__device__ __forceinline__ u32x4 pack8(f32x4 a, f32x4 b) { u32x4 w; w.x = cvt_pk_bf16(a[0], a[1]); w.y = cvt_pk_bf16(a[2], a[3]); w.z = cvt_pk_bf16(b[0], b[1]); w.w = cvt_pk_bf16(b[2], b[3]); return w; }
__device__ __forceinline__ float dot4(f32x4 a, f32x4 b) { return (a[0] * b[0] + a[1] * b[1]) + (a[2] * b[2] + a[3] * b[3]); }
__device__ __forceinline__ f32x4 bf4_to_f32(u32x2 w) { return (f32x4){__uint_as_float(w.x << 16), __uint_as_float(w.x & 0xffff0000u), __uint_as_float(w.y << 16), __uint_as_float(w.y & 0xffff0000u)}; }

struct EpiIn {
    static constexpr bool PERM = true, AFTER_DRAIN = false;
    bf16_t *U, *VA, *Q, *K, *V; float *kout, *vout, *kmp; const float *qn, *kn; float c2, eps;
    __device__ __forceinline__ void operator()(const f32x4 (&acc)[2][2][4][2], const Unit& u, int wr, int wc, int fr, int fq) const {
        const int sec = u.pn >> 1;
        const int cs0 = (u.pn & 1) * 256 + wc * 64 + fq * 8;
        const int rowb = u.pm * BM + wr * 64 + fr;
#ifndef SECM
#define SECM 7
#endif
        if ((SECM & 1) && sec < 2) {
            bf16_t* O = sec == 0 ? U : VA;
#pragma unroll
            for (int ai = 0; ai < 2; ++ai)
#pragma unroll
                for (int m = 0; m < 4; ++m) { bf16_t* rowp = O + (size_t)(rowb + ai * HALF + m * 16) * 512 + cs0;
#pragma unroll
                    for (int bj = 0; bj < 2; ++bj) *(u32x4*)(rowp + 32 * bj) = pack8(gelu4(acc[ai][bj][m][0]), gelu4(acc[ai][bj][m][1])); }
        } else if ((SECM & 2) && sec == 4) {
#pragma unroll
            for (int ai = 0; ai < 2; ++ai)
#pragma unroll
                for (int m = 0; m < 4; ++m) { const size_t off = (size_t)(rowb + ai * HALF + m * 16) * 512 + cs0;
#pragma unroll
                    for (int bj = 0; bj < 2; ++bj) { const f32x4 v0 = acc[ai][bj][m][0], v1 = acc[ai][bj][m][1];
                        *(u32x4*)(V + off + 32 * bj) = pack8(v0, v1); *(f32x4*)(vout + off + 32 * bj) = v0; *(f32x4*)(vout + off + 32 * bj + 4) = v1; } }
        } else if (SECM & 4) {
            const float* gn = sec == 2 ? qn : kn; const float sc = sec == 2 ? c2 : 1.0f;
            f32x4 g[2][2], ks[2][2];
#pragma unroll
            for (int bj = 0; bj < 2; ++bj)
#pragma unroll
                for (int n = 0; n < 2; ++n) { g[bj][n] = *(const f32x4*)(gn + 32 * bj + 8 * fq + 4 * n) * sc; ks[bj][n] = (f32x4){0.f, 0.f, 0.f, 0.f}; }
#pragma unroll
            for (int ai = 0; ai < 2; ++ai)
#pragma unroll
                for (int m = 0; m < 4; ++m) {
                    float ss = (dot4(acc[ai][0][m][0], acc[ai][0][m][0]) + dot4(acc[ai][0][m][1], acc[ai][0][m][1])) + (dot4(acc[ai][1][m][0], acc[ai][1][m][0]) + dot4(acc[ai][1][m][1], acc[ai][1][m][1]));
                    ss += __shfl_xor(ss, 16); ss += __shfl_xor(ss, 32);
                    const float rstd = 1.0f / sqrtf(ss * (1.0f / 64.0f) + eps);
                    const size_t off = (size_t)(rowb + ai * HALF + m * 16) * 512 + cs0;
#pragma unroll
                    for (int bj = 0; bj < 2; ++bj) { const f32x4 o0 = acc[ai][bj][m][0] * rstd * g[bj][0], o1 = acc[ai][bj][m][1] * rstd * g[bj][1];
                        if (sec == 2) { *(u32x4*)(Q + off + 32 * bj) = pack8(o0, o1); }
                        else { *(u32x4*)(K + off + 32 * bj) = pack8(o0, o1); *(f32x4*)(kout + off + 32 * bj) = o0; *(f32x4*)(kout + off + 32 * bj + 4) = o1; ks[bj][0] += o0; ks[bj][1] += o1; } }
                }
            if (sec == 3) {
#pragma unroll
                for (int bj = 0; bj < 2; ++bj)
#pragma unroll
                    for (int n = 0; n < 2; ++n) { f32x4 s = ks[bj][n];
#pragma unroll
                        for (int e = 0; e < 4; ++e) { float x = s[e]; x += __shfl_xor(x, 1); x += __shfl_xor(x, 2); x += __shfl_xor(x, 4); x += __shfl_xor(x, 8); s[e] = x; }
                        if (fr == 0) *(f32x4*)(kmp + (size_t)(u.pm * 2 + wr) * 512 + cs0 + 32 * bj + 4 * n) = s; }
            }
        }
    }
};
struct EpiE {
    static constexpr bool PERM = true, AFTER_DRAIN = false;
    bf16_t* ER; float* sse;
    __device__ __forceinline__ void operator()(const f32x4 (&acc)[2][2][4][2], const Unit& u, int wr, int wc, int fr, int fq) const {
        const int col0 = u.pn * BM + wc * 32 + 8 * fq, rowb = u.pm * BM + wr * 64 + fr;
#pragma unroll
        for (int ai = 0; ai < 2; ++ai)
#pragma unroll
            for (int m = 0; m < 4; ++m) { const int row = rowb + ai * HALF + m * 16; float ss = 0.f;
#pragma unroll
                for (int bj = 0; bj < 2; ++bj) { const f32x4 v0 = acc[ai][bj][m][0], v1 = acc[ai][bj][m][1]; ss += dot4(v0, v0) + dot4(v1, v1);
                    *(u32x4*)(ER + (size_t)row * 1024 + col0 + bj * HALF) = pack8(v0, v1); }
                ss += __shfl_xor(ss, 16); ss += __shfl_xor(ss, 32);
                if (fq == 0) sse[(size_t)row * 16 + u.pn * 4 + wc] = ss; }
    }
};
template <bool BASE_BF16> struct EpiRes {
    static constexpr bool PERM = true, AFTER_DRAIN = true;
    const void* base; bf16_t* hb; float* ss;
    __device__ __forceinline__ void fused(f32x4 (&acc)[2][2][4][2], const Unit& u, int wr, int wc, int fr, int fq, PG8_LAS unsigned char* lds, int wid, int lane) const {
        PG8_LAS float* P = (PG8_LAS float*)lds;
        const int col0 = u.pn * BM + wc * 32 + 8 * fq;
#pragma unroll
        for (int ai = 0; ai < 2; ++ai)
#pragma unroll
            for (int m = 0; m < 4; ++m) { const int rl = ai * HALF + wr * 64 + m * 16 + fr; float s = 0.f;
#pragma unroll
                for (int bj = 0; bj < 2; ++bj) { const size_t off = (size_t)(u.pm * BM + rl) * 1024 + col0 + bj * HALF;
                    f32x4 b0, b1;
                    if (BASE_BF16) { const u32x4 w = *(const u32x4*)((const bf16_t*)base + off); b0 = bf4_to_f32((u32x2){w.x, w.y}); b1 = bf4_to_f32((u32x2){w.z, w.w}); }
                    else { b0 = *(const f32x4*)((const float*)base + off); b1 = *(const f32x4*)((const float*)base + off + 4); }
                    const f32x4 h0 = b0 + acc[ai][bj][m][0], h1 = b1 + acc[ai][bj][m][1];
                    *(u32x4*)(hb + off) = pack8(h0, h1); s += dot4(h0, h0) + dot4(h1, h1); }
                s += __shfl_xor(s, 16); s += __shfl_xor(s, 32);
                if (fq == 0) P[rl * 4 + wc] = s; }
        asm volatile("s_waitcnt lgkmcnt(0)" ::: "memory"); __builtin_amdgcn_s_barrier(); asm volatile("" ::: "memory");
        const int t = wid * 64 + lane;
        if (t < 256) { const f32x4 p = *(const PG8_LAS f32x4*)(P + t * 4); ss[(size_t)(u.pm * BM + t) * 4 + u.pn] = (p[0] + p[1]) + (p[2] + p[3]); }
    }
};
struct EpiUp {
    static constexpr bool PERM = true, AFTER_DRAIN = false;
    bf16_t* HB; const PG8_LAS float* rs;
    __device__ __forceinline__ void operator()(const f32x4 (&acc)[2][2][4][2], const Unit& u, int wr, int wc, int fr, int fq) const {
        const int col0 = u.pn * BM + wc * 32 + 8 * fq;
#pragma unroll
        for (int ai = 0; ai < 2; ++ai)
#pragma unroll
            for (int m = 0; m < 4; ++m) { const int rl = ai * HALF + wr * 64 + m * 16 + fr; const float r = rs[rl]; bf16_t* rowp = HB + (size_t)(u.pm * BM + rl) * 4096 + col0;
#pragma unroll
                for (int bj = 0; bj < 2; ++bj) { f32x4 v0 = acc[ai][bj][m][0] * r, v1 = acc[ai][bj][m][1] * r;
#pragma unroll
                    for (int e = 0; e < 4; ++e) { const float a = fmaxf(v0[e], 0.f), b = fmaxf(v1[e], 0.f); v0[e] = a * a; v1[e] = b * b; }
                    *(u32x4*)(rowp + bj * HALF) = pack8(v0, v1); } }
    }
};
struct EpiPle {
    static constexpr bool PERM = true, AFTER_DRAIN = false;
    const bf16_t* hbase; float* y; const bf16_t* ER; const float* pn; const PG8_LAS float* rs3; const PG8_LAS float* rse;
    __device__ __forceinline__ void operator()(const f32x4 (&acc)[2][2][4][2], const Unit& u, int wr, int wc, int fr, int fq) const {
        const int col0 = u.pn * BM + wc * 32 + 8 * fq;
        f32x4 gn[2][2];
#pragma unroll
        for (int bj = 0; bj < 2; ++bj)
#pragma unroll
            for (int n = 0; n < 2; ++n) gn[bj][n] = *(const f32x4*)(pn + col0 + bj * HALF + 4 * n);
#pragma unroll
        for (int ai = 0; ai < 2; ++ai)
#pragma unroll
            for (int m = 0; m < 4; ++m) { const int rl = ai * HALF + wr * 64 + m * 16 + fr; const float r3 = rs3[rl], re = rse[rl];
#pragma unroll
                for (int bj = 0; bj < 2; ++bj) { const size_t off = (size_t)(u.pm * BM + rl) * 1024 + col0 + bj * HALF;
                    const u32x4 ew = *(const u32x4*)(ER + off); const f32x4 e0 = bf4_to_f32((u32x2){ew.x, ew.y}), e1 = bf4_to_f32((u32x2){ew.z, ew.w});
                    const u32x4 hw = *(const u32x4*)(hbase + off); f32x4 y0 = bf4_to_f32((u32x2){hw.x, hw.y}), y1 = bf4_to_f32((u32x2){hw.z, hw.w});
#pragma unroll
                    for (int e = 0; e < 4; ++e) { const float g0 = __builtin_amdgcn_rcpf(1.0f + __builtin_amdgcn_exp2f(-1.4426950408889634f * r3 * acc[ai][bj][m][0][e]));
                        const float g1 = __builtin_amdgcn_rcpf(1.0f + __builtin_amdgcn_exp2f(-1.4426950408889634f * r3 * acc[ai][bj][m][1][e]));
                        y0[e] += g0 * (e0[e] * re * gn[bj][0][e]); y1[e] += g1 * (e1[e] * re * gn[bj][1][e]); }
                    *(f32x4*)(y + off) = y0; *(f32x4*)(y + off + 4) = y1; } }
    }
};
template <class Epi, class Sched, bool ALIGN_EPI = false, bool SP2 = false>
__device__ __forceinline__ void gemm_phase(PG8_LAS unsigned char* lds, const Gemm g, const Sched& S, const Epi& E) {
    const int tid = threadIdx.x, wid = __builtin_amdgcn_readfirstlane(tid >> 6), lane = tid & 63, wr = wid >> 2, wc = wid & 3, fr = lane & 15, fq = lane >> 4;
    const int K = g.K, nt = K / BK;
    unsigned voffA[2], voffB[2];
#pragma unroll
    for (int i = 0; i < 2; ++i) { int R, C; stage_rc(tid * 16 + i * 8192, R, C); const int Rb = Epi::PERM ? ((R & ~31) + perm32(R & 31)) : R;
        voffA[i] = (unsigned)(R * K + C) * 2u; voffB[i] = (unsigned)(Rb * K + C) * 2u; }
    const size_t kstep = (size_t)(BK * 2);
    const size_t hstep = (size_t)HALF * K * 2;
    const size_t tstep = 2 * hstep;
    const unsigned ldsw = (unsigned)wid * 1024u;
    const int aoff = lds_byte(wr * 64 + fr, fq * 8), boff = lds_byte(wc * 32 + fr, fq * 8);
#define PG8_SA(b, h) (((b) * 2 + (h)) * HTB)
#define PG8_SB(b, h) ((4 + (b) * 2 + (h)) * HTB)
#define PG8_STAGE(bufoff, gbase, voff) do { _Pragma("unroll") for (int _i = 0; _i < 2; ++_i) \
        __builtin_amdgcn_global_load_lds((const unsigned*)((const char*)(gbase) + (voff)[_i]), (PG8_LAS unsigned*)(lds + (bufoff) + ldsw + _i * 8192), 16, 0, 0); } while (0)
#define PG8_LDA(dst, b, h) do { _Pragma("unroll") for (int m = 0; m < 4; ++m) _Pragma("unroll") for (int k = 0; k < 2; ++k) dst[m][k] = *(const PG8_LAS bf16x8*)(lds + PG8_SA(b, h) + aoff + m * 2048 + k * 1024); } while (0)
#define PG8_LDB(dst, b, h) do { _Pragma("unroll") for (int n = 0; n < 2; ++n) _Pragma("unroll") for (int k = 0; k < 2; ++k) dst[n][k] = *(const PG8_LAS bf16x8*)(lds + PG8_SB(b, h) + boff + n * 2048 + k * 1024); } while (0)
#define PG8_MMA(ai, bj, At, Bt) do { __builtin_amdgcn_s_setprio(1); _Pragma("unroll") for (int m = 0; m < 4; ++m) _Pragma("unroll") for (int n = 0; n < 2; ++n) _Pragma("unroll") for (int k = 0; k < 2; ++k) \
        acc[ai][bj][m][n] = __builtin_amdgcn_mfma_f32_16x16x32_bf16(Bt[n][k], At[m][k], acc[ai][bj][m][n], 0, 0, 0); __builtin_amdgcn_s_setprio(0); } while (0)
#define PG8_WAIT_V(n) asm volatile("s_waitcnt vmcnt(" #n ")" ::: "memory")
#define PG8_WAIT_L(n) asm volatile("s_waitcnt lgkmcnt(" #n ")" ::: "memory")
#define PG8_BAR __builtin_amdgcn_s_barrier()
#define PG8_SCHED __builtin_amdgcn_sched_barrier(0)
    Unit cur, nxt; int ui = 0;
    if (!S.next(0, cur)) return;
    f32x4 acc[2][2][4][2];
#pragma unroll
    for (int a = 0; a < 2; ++a)
#pragma unroll
        for (int b = 0; b < 2; ++b)
#pragma unroll
            for (int m = 0; m < 4; ++m)
#pragma unroll
                for (int n = 0; n < 2; ++n) acc[a][b][m][n] = (f32x4){0.f, 0.f, 0.f, 0.f};
    bf16x8 At[4][2], B0[2][2], B1[2][2];
    const char* cA = (const char*)g.A + (size_t)cur.pm * tstep; const char* cB = (const char*)g.Bt + (size_t)cur.pn * tstep;
    S.a_ready(cur);
    if constexpr (SP2) {
        PG8_STAGE(PG8_SB(0, 0), cB, voffB); PG8_STAGE(PG8_SB(0, 1), cB + hstep, voffB); PG8_STAGE(PG8_SA(0, 0), cA, voffA); PG8_STAGE(PG8_SA(0, 1), cA + hstep, voffA);
        if (wr == 1) PG8_BAR;
        PG8_WAIT_V(2); PG8_BAR;
        PG8_STAGE(PG8_SB(1, 0), cB + kstep, voffB); PG8_STAGE(PG8_SA(1, 0), cA + kstep, voffA); PG8_STAGE(PG8_SB(1, 1), cB + hstep + kstep, voffB);
        PG8_WAIT_V(6); PG8_BAR;
    } else {
        PG8_STAGE(PG8_SB(0, 0), cB, voffB); PG8_STAGE(PG8_SA(0, 0), cA, voffA); PG8_STAGE(PG8_SB(0, 1), cB + hstep, voffB); PG8_STAGE(PG8_SA(0, 1), cA + hstep, voffA);
        if (wr == 1) PG8_BAR;
        PG8_WAIT_V(4); PG8_BAR;
        PG8_STAGE(PG8_SB(1, 0), cB + kstep, voffB); PG8_STAGE(PG8_SA(1, 0), cA + kstep, voffA); PG8_STAGE(PG8_SB(1, 1), cB + hstep + kstep, voffB);
        PG8_WAIT_V(6); PG8_BAR;
    }
    for (;;) {
        const bool has_next = S.next(ui + 1, nxt);
        const char* nA = has_next ? (const char*)g.A + (size_t)nxt.pm * tstep : cA; const char* nB = has_next ? (const char*)g.Bt + (size_t)nxt.pn * tstep : cB;
        for (int t = 0; t < nt; t += 2) {
            const bool last = (t == nt - 2);
            const char* a1 = cA + (size_t)(t + 1) * kstep;
            const char* a2 = last ? nA : cA + (size_t)(t + 2) * kstep; const char* b2 = last ? nB : cB + (size_t)(t + 2) * kstep;
            const char* a3 = a2 + kstep; const char* b3 = b2 + kstep;
            if (last && has_next) S.a_ready(nxt);
            if constexpr (SP2) {
            PG8_LDB(B0, 0, 0); PG8_LDB(B1, 0, 1); PG8_SCHED; PG8_LDA(At, 0, 0); PG8_STAGE(PG8_SA(1, 1), a1 + hstep, voffA);
            PG8_WAIT_V(8); PG8_WAIT_L(0); PG8_BAR; PG8_MMA(0, 0, At, B0); PG8_MMA(0, 1, At, B1); PG8_BAR; PG8_SCHED;
            PG8_LDA(At, 0, 1); PG8_STAGE(PG8_SB(0, 0), b2, voffB); PG8_STAGE(PG8_SB(0, 1), b2 + hstep, voffB); PG8_STAGE(PG8_SA(0, 0), a2, voffA);
            PG8_WAIT_V(8); PG8_WAIT_L(0); PG8_BAR; PG8_MMA(1, 0, At, B0); PG8_MMA(1, 1, At, B1); PG8_BAR; PG8_SCHED;
            PG8_LDB(B0, 1, 0); PG8_LDB(B1, 1, 1); PG8_SCHED; PG8_LDA(At, 1, 0); PG8_STAGE(PG8_SA(0, 1), a2 + hstep, voffA);
            PG8_WAIT_V(8); PG8_WAIT_L(0); PG8_BAR; PG8_MMA(0, 0, At, B0); PG8_MMA(0, 1, At, B1); PG8_BAR; PG8_SCHED;
            PG8_LDA(At, 1, 1); PG8_STAGE(PG8_SB(1, 0), b3, voffB); PG8_STAGE(PG8_SB(1, 1), b3 + hstep, voffB); PG8_STAGE(PG8_SA(1, 0), a3, voffA);
            PG8_WAIT_V(8); PG8_WAIT_L(0); PG8_BAR; PG8_MMA(1, 0, At, B0); PG8_MMA(1, 1, At, B1); PG8_BAR; PG8_SCHED;
            } else {
            PG8_LDB(B0, 0, 0); PG8_SCHED; PG8_LDA(At, 0, 0); PG8_STAGE(PG8_SA(1, 1), a1 + hstep, voffA);
            PG8_WAIT_L(8); PG8_BAR; PG8_WAIT_L(0); PG8_MMA(0, 0, At, B0); PG8_BAR; PG8_SCHED;
            PG8_LDB(B1, 0, 1); PG8_STAGE(PG8_SB(0, 0), b2, voffB);
            PG8_BAR; PG8_WAIT_L(0); PG8_MMA(0, 1, At, B1); PG8_BAR;
            PG8_LDA(At, 0, 1); PG8_STAGE(PG8_SA(0, 0), a2, voffA);
            PG8_BAR; PG8_WAIT_L(0); PG8_MMA(1, 0, At, B0); PG8_BAR; PG8_SCHED;
            PG8_STAGE(PG8_SB(0, 1), b2 + hstep, voffB);
            PG8_WAIT_V(6); PG8_BAR; PG8_MMA(1, 1, At, B1); PG8_BAR;
            PG8_LDB(B0, 1, 0); PG8_SCHED; PG8_LDA(At, 1, 0); PG8_STAGE(PG8_SA(0, 1), a2 + hstep, voffA);
            PG8_WAIT_L(8); PG8_BAR; PG8_WAIT_L(0); PG8_MMA(0, 0, At, B0); PG8_BAR; PG8_SCHED;
            PG8_LDB(B1, 1, 1); PG8_STAGE(PG8_SB(1, 0), b3, voffB);
            PG8_BAR; PG8_WAIT_L(0); PG8_MMA(0, 1, At, B1); PG8_BAR;
            PG8_LDA(At, 1, 1); PG8_STAGE(PG8_SA(1, 0), a3, voffA);
            PG8_BAR; PG8_WAIT_L(0); PG8_MMA(1, 0, At, B0); PG8_BAR; PG8_SCHED;
            PG8_STAGE(PG8_SB(1, 1), b3 + hstep, voffB);
            PG8_WAIT_V(6); PG8_BAR; PG8_MMA(1, 1, At, B1); PG8_BAR;
            }
        }
        if constexpr (ALIGN_EPI) { if (wr == 0) PG8_BAR; }
        if constexpr (!Epi::AFTER_DRAIN) { E(acc, cur, wr, wc, fr, fq); S.done(cur); }
        if (!has_next) break;
#pragma unroll
        for (int a = 0; a < 2; ++a)
#pragma unroll
            for (int b = 0; b < 2; ++b)
#pragma unroll
                for (int m = 0; m < 4; ++m)
#pragma unroll
                    for (int n = 0; n < 2; ++n) acc[a][b][m][n] = (f32x4){0.f, 0.f, 0.f, 0.f};
        cur = nxt; cA = nA; cB = nB; ++ui;
        if constexpr (ALIGN_EPI) { if (wr == 1) PG8_BAR; }
    }
    PG8_WAIT_V(0);
    if constexpr (!ALIGN_EPI) { if (wr == 0) PG8_BAR; }
    PG8_BAR;
    if constexpr (Epi::AFTER_DRAIN) { E.fused(acc, cur, wr, wc, fr, fq, lds, wid, lane); S.done(cur); }
#undef PG8_SA
#undef PG8_SB
#undef PG8_STAGE
#undef PG8_LDA
#undef PG8_LDB
#undef PG8_MMA
#undef PG8_WAIT_V
#undef PG8_WAIT_L
#undef PG8_BAR
#undef PG8_SCHED
}
}
#ifndef PG8_SP2
#define PG8_SP2 true
#endif
#define GAS __attribute__((address_space(1)))
#define LAS __attribute__((address_space(3)))
typedef unsigned short bf16;
typedef unsigned v4u __attribute__((ext_vector_type(4)));
typedef float f32x4 __attribute__((ext_vector_type(4)));
typedef short bf16x8 __attribute__((ext_vector_type(8)));
typedef GAS unsigned gu32;
typedef GAS unsigned long long gu64;
#define RLX_AGENT __ATOMIC_RELAXED, __HIP_MEMORY_SCOPE_AGENT
#define LDS_WAIT() asm volatile("s_waitcnt lgkmcnt(0)" ::: "memory")
#define VM_WAIT() asm volatile("s_waitcnt vmcnt(0)" ::: "memory")
__device__ __forceinline__ unsigned long long rt() { return __builtin_amdgcn_s_memrealtime(); }
__device__ __forceinline__ unsigned f2bf(float f) { unsigned u = __builtin_bit_cast(unsigned, f); return (u + 0x7fffu + ((u >> 16) & 1u)) >> 16; }
__device__ __forceinline__ unsigned pk2(float lo, float hi) { return f2bf(lo) | (f2bf(hi) << 16); }

#define XB_TMO      128
#define XB_XCNT(j)  (256  + 64 * (j))
#define XB_XSUB(j)  (1280 + 64 * (j))
#define XB_XGEN(j)  (2304 + 64 * (j))
#define XB_TOP      3328
#define XB_TOPGEN   3392
#define XCD_BAR_WORDS 3456
#define XB_SPIN_CAP (1u << 18)

__device__ __forceinline__ unsigned xb_ld(unsigned* p)              { return __hip_atomic_load(p, __ATOMIC_RELAXED, __HIP_MEMORY_SCOPE_AGENT); }
__device__ __forceinline__ unsigned xb_add(unsigned* p, unsigned v) { return __hip_atomic_fetch_add(p, v, __ATOMIC_RELAXED, __HIP_MEMORY_SCOPE_AGENT); }
__device__ __forceinline__ unsigned xb_xcc_id() { return (unsigned)__builtin_amdgcn_s_getreg((3 << 11) | 20) & 0xFu; }
#define XB_SPIN(cond, bar) do { unsigned _sp = 0; while (cond) { __builtin_amdgcn_s_sleep(1); \
    if ((++_sp & 255u) == 0u) { if (xb_ld(&(bar)[XB_TMO])) break; if (_sp > XB_SPIN_CAP) { atomicAdd(&(bar)[XB_TMO], 1u); break; } } } } while (0)

struct XcdBarrier {
    unsigned* bar; unsigned x;
    volatile LAS unsigned* st;
};

__device__ __forceinline__ XcdBarrier xcd_barrier_post(unsigned* bar, volatile LAS unsigned* st) {
    XcdBarrier b; b.bar = bar; b.x = xb_xcc_id(); b.st = st;
    if (threadIdx.x == 0) (void)xb_add(&bar[XB_XCNT(b.x)], 1u);
    return b;
}
__device__ __forceinline__ void xcd_barrier_complete(unsigned* bar, unsigned x, unsigned& nloc, unsigned& nx) {
    const unsigned G = gridDim.x * gridDim.y * gridDim.z;
    unsigned sum, cnt, mine, sp = 0u;
    for (;;) {
        sum = 0u; cnt = 0u; mine = 0u;
#pragma unroll
        for (unsigned j = 0; j < 16; ++j) { const unsigned c = xb_ld(&bar[XB_XCNT(j)]); sum += c; cnt += (c > 0u) ? 1u : 0u; mine = (j == x) ? c : mine; }
        if (sum == G) break;
        __builtin_amdgcn_s_sleep(1);
        if ((++sp & 255u) == 0u) { if (xb_ld(&bar[XB_TMO])) break; if (sp > XB_SPIN_CAP) { atomicAdd(&bar[XB_TMO], 1u); break; } }
    }
    nloc = mine > 0u ? mine : 1u; nx = cnt > 0u ? cnt : 1u;
}

__device__ __forceinline__ void xcd_barrier(const XcdBarrier& b) {
    asm volatile("s_waitcnt vmcnt(0)" ::: "memory");
    __syncthreads();
    if (threadIdx.x == 0) {
        unsigned* bar = b.bar;
        __builtin_amdgcn_s_waitcnt(0);
        unsigned nloc = b.st[0], nx = b.st[1];
        if (nloc == 0u) { xcd_barrier_complete(bar, b.x, nloc, nx); b.st[0] = nloc; b.st[1] = nx; }
        const unsigned old = xb_add(&bar[XB_XSUB(b.x)], 1u);
        const unsigned gen = old / nloc;
        if (old + 1u == (gen + 1u) * nloc) {
            __builtin_amdgcn_fence(__ATOMIC_RELEASE, "agent");
            asm volatile("s_waitcnt vmcnt(0)" ::: "memory");
            const unsigned og = xb_add(&bar[XB_TOP], 1u);
            const unsigned tg = og / nx;
            if (og + 1u == (tg + 1u) * nx) xb_add(&bar[XB_TOPGEN], 1u);
            else XB_SPIN(xb_ld(&bar[XB_TOPGEN]) == tg, bar);
            __builtin_amdgcn_fence(__ATOMIC_ACQUIRE, "agent");
            xb_add(&bar[XB_XGEN(b.x)], 1u);
            asm volatile("s_waitcnt vmcnt(0)" ::: "memory");
        } else {
            XB_SPIN(xb_ld(&bar[XB_XGEN(b.x)]) == gen, bar);
            __builtin_amdgcn_fence(__ATOMIC_ACQUIRE, "agent");
            asm volatile("s_waitcnt vmcnt(0)" ::: "memory");
        }
    }
    __syncthreads();
}
typedef unsigned u32x2 __attribute__((ext_vector_type(2)));
#include <hip/hip_bf16.h>
#include <cmath>
namespace attn_body {
using bf16=__hip_bfloat16;
using bf16x8=__attribute__((ext_vector_type(8)))short;
using s16x4=__attribute__((ext_vector_type(4)))short;
using f32x16=__attribute__((ext_vector_type(16)))float;
using u32x4=__attribute__((ext_vector_type(4)))unsigned;
using f32x4_t=__attribute__((ext_vector_type(4)))float;
constexpr int BATCH=8,NHEAD=8,SEQ=2048,D=64,DM=NHEAD*D,OP=1024,OCOL=512;
constexpr int NW=8,QBLK=32,QB=QBLK*NW,KVBLK=64,NQB=SEQ/QB;
constexpr int ATTN_PITCH=DM, ATTN_UNIT_ROWS=QB;
__device__ __forceinline__ int crow(int r,int hi){return (r&3)+8*(r>>2)+4*hi;}
#define SBAR() __builtin_amdgcn_sched_barrier(0)
__device__ __forceinline__ void cmask(f32x16&p0,f32x16&p1,int jb,int qrel,int hi){
  const float NEG=-INFINITY; int lim=qrel-(64*jb+4*hi); asm volatile("":"+v"(lim));
  #pragma unroll
  for(int r=0;r<16;++r){const int c=(r&3)+8*(r>>2); if(c>lim)p0[r]=NEG; if(c+32>lim)p1[r]=NEG;}
}

constexpr int NSLOT=3, SLOTB=8192;
constexpr int LDS_K=0, LDS_V=NSLOT*SLOTB, LDS_WS=2*NSLOT*SLOTB, LDS_OST=LDS_WS+NW*64*4, LDS_KM=LDS_OST+NW*4096, LDS_BYTES=LDS_KM+7*64*4;
constexpr float C2=0.125f*1.4426950408889634f;
__device__ __forceinline__ void glds16(const void*gsrc,unsigned lds_dst){unsigned keep;
  asm volatile("s_mov_b32 %0, m0\n\ts_mov_b32 m0, %2\n\ts_nop 0\n\tglobal_load_lds_dwordx4 %1, off\n\ts_mov_b32 m0, %0":"=&s"(keep):"v"(gsrc),"s"(lds_dst):"memory");}
__device__ __forceinline__ float max3f(float a,float b,float c){float r;asm("v_max3_f32 %0, %1, %2, %3":"=v"(r):"v"(a),"v"(b),"v"(c));return r;}
__device__ __forceinline__ float max2f(float a,float b){float r;asm("v_max_f32_e32 %0, %1, %2":"=v"(r):"v"(a),"v"(b));return r;}
__device__ __forceinline__ float fadd_s(float a,float b){float r;asm("v_add_f32_e32 %0, %1, %2":"=v"(r):"v"(a),"v"(b));return r;}
__device__ __forceinline__ float fsub_s(float a,float b){float r;asm("v_sub_f32_e32 %0, %1, %2":"=v"(r):"v"(a),"v"(b));return r;}
typedef float f32x2_t __attribute__((ext_vector_type(2))); typedef __bf16 bf16x2_t __attribute__((ext_vector_type(2)));
__device__ __forceinline__ unsigned cvtpk_s(float lo,float hi){f32x2_t v={lo,hi};bf16x2_t b=__builtin_convertvector(v,bf16x2_t);return __builtin_bit_cast(unsigned,b);}
#define WAIT_BAR(N) asm volatile("s_waitcnt vmcnt(" #N ") lgkmcnt(0)\n\ts_barrier":::"memory")

__device__ __forceinline__ void qkt(f32x16&p0,f32x16&p1,const char*Kslot,const bf16x8*qr,const f32x16&negm,int r32,int hi){
  const char*kb=Kslot+hi*1024+r32*16;
  #pragma unroll
  for(int d0=0;d0<4;++d0){
    const bf16x8 b0=*reinterpret_cast<const bf16x8*>(kb+d0*2048);
    const bf16x8 b1=*reinterpret_cast<const bf16x8*>(kb+d0*2048+512);
    if(d0==0){p0=__builtin_amdgcn_mfma_f32_32x32x16_bf16(b0,qr[0],negm,0,0,0);p1=__builtin_amdgcn_mfma_f32_32x32x16_bf16(b1,qr[0],negm,0,0,0);}
    else{p0=__builtin_amdgcn_mfma_f32_32x32x16_bf16(b0,qr[d0],p0,0,0,0);p1=__builtin_amdgcn_mfma_f32_32x32x16_bf16(b1,qr[d0],p1,0,0,0);}}
}
typedef __attribute__((address_space(3))) const char* lds_cptr;
typedef short v4i16_t __attribute__((ext_vector_type(4)));
__device__ __forceinline__ void kload8(bf16x8*kf,lds_cptr kp){
  kf[0]=*(const __attribute__((address_space(3))) bf16x8*)(kp);      kf[1]=*(const __attribute__((address_space(3))) bf16x8*)(kp+512);
  kf[2]=*(const __attribute__((address_space(3))) bf16x8*)(kp+2048); kf[3]=*(const __attribute__((address_space(3))) bf16x8*)(kp+2560);
  kf[4]=*(const __attribute__((address_space(3))) bf16x8*)(kp+4096); kf[5]=*(const __attribute__((address_space(3))) bf16x8*)(kp+4608);
  kf[6]=*(const __attribute__((address_space(3))) bf16x8*)(kp+6144); kf[7]=*(const __attribute__((address_space(3))) bf16x8*)(kp+6656);
}
__device__ __forceinline__ void kload2(bf16x8*kf,lds_cptr kp,int j){ kf[2*j]=*(const __attribute__((address_space(3))) bf16x8*)(kp+j*2048); kf[2*j+1]=*(const __attribute__((address_space(3))) bf16x8*)(kp+j*2048+512); }
__device__ __forceinline__ s16x4 vtr(lds_cptr p){ return __builtin_bit_cast(s16x4,__builtin_amdgcn_ds_read_tr16_b64_v4i16((__attribute__((address_space(3))) v4i16_t*)p)); }
__device__ __forceinline__ float rowmax(const f32x16&p0,const f32x16&p1){
  float a=max3f(p0[0],p0[1],p1[0]),b=max3f(p0[2],p0[3],p1[1]);a=max3f(a,p1[2],p1[3]);
  #pragma unroll
  for(int r=4;r<16;r+=4){a=max3f(a,p0[r],p0[r+1]);b=max3f(b,p0[r+2],p0[r+3]);a=max3f(a,p1[r],p1[r+1]);b=max3f(b,p1[r+2],p1[r+3]);}
  const float m=max2f(a,b);
  auto rr=__builtin_amdgcn_permlane32_swap(__float_as_uint(m),__float_as_uint(m),false,false);
  return max2f(__uint_as_float(rr[0]),__uint_as_float(rr[1]));
}
__device__ __forceinline__ void pv(f32x16*o,int vb,bf16x8 pa0,bf16x8 pa1,bf16x8 pa2,bf16x8 pa3){
  #pragma unroll
  for(int d0=0;d0<2;++d0){s16x4 lo[4],hi[4];
    #pragma unroll
    for(int ks=0;ks<4;++ks){
      asm volatile("ds_read_b64_tr_b16 %0,%1 offset:%c2":"=&v"(lo[ks]):"v"(vb),"i"(d0*4096+ks*1024):"memory");
      asm volatile("ds_read_b64_tr_b16 %0,%1 offset:%c2":"=&v"(hi[ks]):"v"(vb),"i"(d0*4096+ks*1024+512):"memory");}
    asm volatile("s_waitcnt lgkmcnt(0)":::"memory");SBAR();
    #define PK(k) (bf16x8){lo[k][0],lo[k][1],lo[k][2],lo[k][3],hi[k][0],hi[k][1],hi[k][2],hi[k][3]}
    o[d0]=__builtin_amdgcn_mfma_f32_32x32x16_bf16(pa0,PK(0),o[d0],0,0,0);
    o[d0]=__builtin_amdgcn_mfma_f32_32x32x16_bf16(pa1,PK(1),o[d0],0,0,0);
    o[d0]=__builtin_amdgcn_mfma_f32_32x32x16_bf16(pa2,PK(2),o[d0],0,0,0);
    o[d0]=__builtin_amdgcn_mfma_f32_32x32x16_bf16(pa3,PK(3),o[d0],0,0,0);
    #undef PK
  }
}

#ifndef ATTN_STORE16
#define ATTN_STORE16(p,v) (*(u32x4*)(p)=(v))
#endif
template<int THRL> __device__ __forceinline__ void attn_unit(int b,int h,int qb,const bf16*Q,const bf16*__restrict__ K,const bf16*__restrict__ V,bf16*O,const float*__restrict__ KMP,char*shm){
  const int tid=threadIdx.x,lane=tid&63,r32=lane&31,hi=lane>>5; const int wid=__builtin_amdgcn_readfirstlane(tid>>6);
  const long rowbase=(long)b*SEQ; const int q0=qb*QB;
  const bf16*Qw=Q+(rowbase+q0+wid*QBLK)*DM+h*D;
  const bf16*Kh=K+rowbase*DM+h*D,*Vh=V+rowbase*DM+h*D;
  const unsigned lds0=(unsigned)(uintptr_t)shm;
  float*wsf=(float*)(shm+LDS_WS)+wid*64;
  const bf16*ksrc=Kh+(long)lane*DM+wid*8;
  const bf16*vsrc=Vh+(long)(16*(wid&3)+(lane>>2))*DM+(wid>>2)*32+(lane&3)*8;
  const unsigned kdst=lds0+LDS_K+wid*1024, vdst=lds0+LDS_V+wid*1024;
  #define DMA_K(t,slot) glds16(ksrc+(long)TMAP(t)*KVBLK*DM,(unsigned)__builtin_amdgcn_readfirstlane(kdst+(slot)))
  #define DMA_V(t,slot) glds16(vsrc+(long)TMAP(t)*KVBLK*DM,(unsigned)__builtin_amdgcn_readfirstlane(vdst+(slot)))
  const int vb0=(int)(lds0+LDS_V)+((lane>>4)&1)*32+(lane&3)*8+(4*hi+((lane&15)>>2))*64;
  const char*Kbase=shm+LDS_K; bf16x8 kf[8];
  const lds_cptr shm3=(lds_cptr)shm; const lds_cptr kp0=shm3+LDS_K+hi*1024+r32*16; const lds_cptr vp0=shm3+LDS_V+((lane>>4)&1)*32+(lane&3)*8+(4*hi+((lane&15)>>2))*64;
  const int NT=(q0+QB)/KVBLK;
  #define TMAP(t) ((t)<4?NT-4+(t):(t)-4)
  __attribute__((address_space(3))) float*kmf=(__attribute__((address_space(3))) float*)((__attribute__((address_space(3))) char*)shm+LDS_KM);
  if(tid<qb*64){const int j=tid>>6,d=tid&63;const float*kp=KMP+(long)((b*8+j)*2)*512+h*64+d;kmf[tid]=(kp[0]+kp[512])*(1.0f/256.0f);}
  DMA_K(0,0);DMA_V(0,0);DMA_K(1,SLOTB);
  bf16x8 qr[4];
  #pragma unroll
  for(int d0=0;d0<4;++d0)qr[d0]=*reinterpret_cast<const bf16x8*>(&Qw[(long)r32*DM+d0*16+hi*8]);
  float mhat=0.f,l_reg=0.f;f32x16 o[2],negm;{float z_=0.f;asm volatile("":"+v"(z_)); _Pragma("unroll") for(int r=0;r<16;++r){o[0][r]=z_;o[1][r]=z_;negm[r]=z_;}}asm volatile("":"+v"(negm));
  const int qrel=wid*QBLK+r32;
  #define CMASK(P0,P1,t) do{ if((t)<4)cmask(P0,P1,(t),qrel,hi); }while(0)
  bool resc=false;
  #define START(P0,P1) do{ const float rm=rowmax(P0,P1); resc=false; \
    { const float dl=rm; mhat=fadd_s(mhat,dl); \
      _Pragma("unroll") for(int r=0;r<16;++r){P0[r]=fsub_s(P0[r],dl);P1[r]=fsub_s(P1[r],dl);} \
      _Pragma("unroll") for(int r=0;r<16;++r)negm[r]=-mhat; asm volatile("":"+v"(negm)); } \
    _Pragma("unroll") for(int r=0;r<16;++r)P0[r]=__builtin_amdgcn_exp2f(P0[r]); }while(0)
  #define RESC() do{ if(resc){ asm volatile("s_waitcnt lgkmcnt(0)":::"memory"); \
      _Pragma("unroll") for(int d_=0;d_<2;++d_) _Pragma("unroll") for(int r=0;r<16;++r)o[d_][r]*=wsf[crow(r,hi)]; } }while(0)
  f32x16 pA0,pA1,pB0,pB1;
  int sl_prev=0,sl_cur=0,sl_next=SLOTB;
  #define ROT() do{sl_prev=sl_cur;sl_cur=sl_next;sl_next=(sl_next==(NSLOT-1)*SLOTB)?0:sl_next+SLOTB;}while(0)
  DMA_K(2,2*SLOTB);
  WAIT_BAR(3);
  unsigned sel=0xffu; bool selc=true;
  if(qb>=4){ float g[7];
    _Pragma("unroll") for(int j=0;j<7;++j){ float s=-INFINITY;
      if(j<qb){ s=0.f; _Pragma("unroll") for(int d0=0;d0<4;++d0){ const __attribute__((address_space(3))) float*kp=kmf+j*64+16*d0+8*hi; const f32x4_t a=*(const __attribute__((address_space(3))) f32x4_t*)kp,c=*(const __attribute__((address_space(3))) f32x4_t*)(kp+4);
          _Pragma("unroll") for(int e=0;e<4;++e){ s+=__uint_as_float((unsigned)(unsigned short)qr[d0][e]<<16)*a[e]; s+=__uint_as_float((unsigned)(unsigned short)qr[d0][4+e]<<16)*c[e]; } }
        auto rr=__builtin_amdgcn_permlane32_swap(__float_as_uint(s),__float_as_uint(s),false,false); s=__uint_as_float(rr[0])+__uint_as_float(rr[1]); }
      g[j]=s; }
    sel=0u;
    _Pragma("unroll") for(int j=0;j<7;++j){ int rank=0; _Pragma("unroll") for(int i=0;i<7;++i) if(i!=j) rank+=(g[i]>g[j]||(g[i]==g[j]&&i<j))?1:0; if(j<qb&&rank<3)sel|=1u<<j; } }
  qkt(pA0,pA1,Kbase,qr,negm,r32,hi);asm volatile("s_nop 15\n\ts_nop 7":"+v"(pA0),"+v"(pA1));CMASK(pA0,pA1,0);
  START(pA0,pA1);
  _Pragma("unroll") for(int r=0;r<16;++r)pA1[r]=__builtin_amdgcn_exp2f(pA1[r]);
  WAIT_BAR(0);
  DMA_K(3,0);DMA_V(1,SLOTB);
  ROT();
  kload8(kf,kp0+sl_cur);
  WAIT_BAR(2);
  s16x4 vlo[8],vhi[8]; u32x4 pw0,pw1,pw2,pw3;
  #define PKW(P,B) cvtpk_s(P[B],P[B+1])
  #define PAF(k) __builtin_bit_cast(bf16x8,pw##k)
  #define VFR(i) (bf16x8){vlo[i][0],vlo[i][1],vlo[i][2],vlo[i][3],vhi[i][0],vhi[i][1],vhi[i][2],vhi[i][3]}
  #define PIN(x) asm volatile("":"+v"(x))
  #define MX3(a,b,c) __builtin_fmaxf(__builtin_fmaxf((a),(b)),(c))
  #define GAPA(MF,A0,A1,A2,A3,W0,W1,PW) do{ MF; sacc+=A0; sacc+=A1; sacc+=A2; sacc+=A3; PIN(sacc); W0; W1; PIN(PW); SBAR(); }while(0)
  #define EX(v) __builtin_amdgcn_exp2f(v)
  #define GAPB(MF,X,B) do{ MF; X[B]=EX(X[B]); X[B+1]=EX(X[B+1]); X[B+2]=EX(X[B+2]); X[B+3]=EX(X[B+3]); PIN(X); SBAR(); }while(0)
  #define VRD(i) do{ vlo[i]=vtr(vp_+(((i)>>2)*4096+((i)&3)*1024)); vhi[i]=vtr(vp_+(((i)>>2)*4096+((i)&3)*1024+512)); }while(0)
  #define KRD(G,j) do{ if(G){ kload2(kf,kp0+sl_next,j); SBAR(); } }while(0)
  #define STEP(C0,C1,P0,P1,t,GK,GV,GL) do{ SBAR(); \
    const lds_cptr vp_=vp0+sl_prev; \
    VRD(0); SBAR(); float sacc=(P0[0]+P0[1]); \
    GAPA(C0=__builtin_amdgcn_mfma_f32_32x32x16_bf16(kf[0],qr[0],negm,0,0,0), P0[2],P0[3],P0[4],P0[5],     pw0[0]=PKW(P0,0), pw0[1]=PKW(P0,2), pw0); \
    VRD(4); SBAR(); GAPA(C1=__builtin_amdgcn_mfma_f32_32x32x16_bf16(kf[1],qr[0],negm,0,0,0), P0[6],P0[7],P0[8],P0[9],     pw0[2]=PKW(P0,4), pw0[3]=PKW(P0,6), pw0); \
    VRD(1); SBAR(); GAPA(C0=__builtin_amdgcn_mfma_f32_32x32x16_bf16(kf[2],qr[1],C0,0,0,0),   P0[10],P0[11],P0[12],P0[13], pw1[0]=PKW(P0,8), pw1[1]=PKW(P0,10), pw1); \
    VRD(5); SBAR(); GAPA(C1=__builtin_amdgcn_mfma_f32_32x32x16_bf16(kf[3],qr[1],C1,0,0,0),   P0[14],P0[15],P1[0],P1[1],   pw1[2]=PKW(P0,12),pw1[3]=PKW(P0,14), pw1); \
    VRD(2); SBAR(); GAPA(C0=__builtin_amdgcn_mfma_f32_32x32x16_bf16(kf[4],qr[2],C0,0,0,0),   P1[2],P1[3],P1[4],P1[5],     pw2[0]=PKW(P1,0), pw2[1]=PKW(P1,2), pw2); \
    VRD(6); SBAR(); GAPA(C1=__builtin_amdgcn_mfma_f32_32x32x16_bf16(kf[5],qr[2],C1,0,0,0),   P1[6],P1[7],P1[8],P1[9],     pw2[2]=PKW(P1,4), pw2[3]=PKW(P1,6), pw2); \
    VRD(3); SBAR(); GAPA(C0=__builtin_amdgcn_mfma_f32_32x32x16_bf16(kf[6],qr[3],C0,0,0,0),   P1[10],P1[11],P1[12],P1[13], pw3[0]=PKW(P1,8), pw3[1]=PKW(P1,10), pw3); \
    VRD(7); SBAR(); GAPA(C1=__builtin_amdgcn_mfma_f32_32x32x16_bf16(kf[7],qr[3],C1,0,0,0),   P1[14],P1[15],0.f,0.f,       pw3[2]=PKW(P1,12),pw3[3]=PKW(P1,14), pw3); \
    l_reg+=sacc; \
    if(GK){DMA_K((t)+3,sl_cur);} if(GV){DMA_V((t)+1,sl_next);} \
    CMASK(C0,C1,t); \
    { float a=MX3(C0[0],C0[1],C1[0]),b=MX3(C0[2],C0[3],C1[1]); a=MX3(a,C1[2],C1[3]); \
      _Pragma("unroll") for(int r=4;r<16;r+=4){a=MX3(a,C0[r],C0[r+1]);b=MX3(b,C0[r+2],C0[r+3]);a=MX3(a,C1[r],C1[r+1]);b=MX3(b,C1[r+2],C1[r+3]);} \
      float rm=__builtin_fmaxf(a,b); { auto rr=__builtin_amdgcn_permlane32_swap(__float_as_uint(rm),__float_as_uint(rm),false,false); rm=__builtin_fmaxf(__uint_as_float(rr[0]),__uint_as_float(rr[1])); } \
      resc=false; \
      if(__builtin_expect(__any(rm>(float)THRL),0)){ const float dl=__builtin_fmaxf(rm,0.f); mhat+=dl; \
        _Pragma("unroll") for(int r=0;r<16;++r){C0[r]-=dl;C1[r]-=dl;} \
        { const float nm_=selc?-mhat:-INFINITY; _Pragma("unroll") for(int r=0;r<16;++r)negm[r]=nm_; } asm volatile("":"+v"(negm)); \
        const float f=__builtin_amdgcn_exp2f(-dl); l_reg*=f; if(hi==0)wsf[r32]=f; resc=true; } } \
    SBAR(); \
    GAPB(o[0]=__builtin_amdgcn_mfma_f32_32x32x16_bf16(PAF(0),VFR(0),o[0],0,0,0), C0,0); \
    GAPB(o[1]=__builtin_amdgcn_mfma_f32_32x32x16_bf16(PAF(0),VFR(4),o[1],0,0,0), C0,4); \
    KRD(GL,0); GAPB(o[0]=__builtin_amdgcn_mfma_f32_32x32x16_bf16(PAF(1),VFR(1),o[0],0,0,0), C0,8); \
    KRD(GL,1); GAPB(o[1]=__builtin_amdgcn_mfma_f32_32x32x16_bf16(PAF(1),VFR(5),o[1],0,0,0), C0,12); \
    KRD(GL,2); GAPB(o[0]=__builtin_amdgcn_mfma_f32_32x32x16_bf16(PAF(2),VFR(2),o[0],0,0,0), C1,0); \
    KRD(GL,3); GAPB(o[1]=__builtin_amdgcn_mfma_f32_32x32x16_bf16(PAF(2),VFR(6),o[1],0,0,0), C1,4); \
    GAPB(o[0]=__builtin_amdgcn_mfma_f32_32x32x16_bf16(PAF(3),VFR(3),o[0],0,0,0), C1,8); \
    GAPB(o[1]=__builtin_amdgcn_mfma_f32_32x32x16_bf16(PAF(3),VFR(7),o[1],0,0,0), C1,12); \
    }while(0)
  int t=1;
  #define ENDW(tt) do{ if((tt)+3<NT){WAIT_BAR(2);} else if((tt)+2<NT){WAIT_BAR(1);} else {WAIT_BAR(0);} }while(0)
  #define BLK(tt) do{ if((tt)>=4&&((tt)&3)==0){ selc=((sel>>(((tt)-4)>>2))&1u)!=0u; const float nm_=selc?-mhat:-INFINITY; _Pragma("unroll") for(int r=0;r<16;++r)negm[r]=nm_; asm volatile("":"+v"(negm)); } }while(0)
  for(;t+1<NT;t+=2){
    STEP(pB0,pB1,pA0,pA1,t,(t+3<NT),(t+1<NT),(t+1<NT));       ENDW(t);   RESC(); ROT();
    BLK(t+1);
    STEP(pA0,pA1,pB0,pB1,t+1,(t+4<NT),(t+2<NT),(t+2<NT));     ENDW(t+1); RESC(); ROT();
  }
  STEP(pB0,pB1,pA0,pA1,NT-1,false,false,false); RESC();
  { float sacc=pB0[0]+pB0[1]; _Pragma("unroll") for(int r=2;r<16;++r)sacc+=pB0[r]; _Pragma("unroll") for(int r=0;r<16;++r)sacc+=pB1[r]; l_reg+=sacc;
    pw0=(u32x4){PKW(pB0,0),PKW(pB0,2),PKW(pB0,4),PKW(pB0,6)};pw1=(u32x4){PKW(pB0,8),PKW(pB0,10),PKW(pB0,12),PKW(pB0,14)};pw2=(u32x4){PKW(pB1,0),PKW(pB1,2),PKW(pB1,4),PKW(pB1,6)};pw3=(u32x4){PKW(pB1,8),PKW(pB1,10),PKW(pB1,12),PKW(pB1,14)};
    SBAR(); pv(o,vb0+sl_cur,PAF(0),PAF(1),PAF(2),PAF(3)); }
  #undef PKW
  #undef PAF
  #undef VFR
  #undef PIN
  #undef MX3
  #undef GAPA
  #undef GAPB
  #undef EX
  #undef VRD
  #undef KRD
  #undef STEP
  #undef ENDW
  #undef BLK
  {auto rr=__builtin_amdgcn_permlane32_swap(__float_as_uint(l_reg),__float_as_uint(l_reg),false,false);l_reg=__uint_as_float(rr[0])+__uint_as_float(rr[1]);}
  if(hi==0)wsf[32+r32]=l_reg;asm volatile("s_waitcnt lgkmcnt(0)":::"memory");
  float rli[16];
  #pragma unroll
  for(int r=0;r<16;++r)rli[r]=__builtin_amdgcn_rcpf(wsf[32+crow(r,hi)]);
  bf16*Ow=O+(rowbase+q0+wid*QBLK)*OP+OCOL+h*D;
  { bf16*stg=(bf16*)(shm+LDS_OST)+wid*2048;
    #pragma unroll
    for(int r=0;r<16;++r){const int orow=crow(r,hi);
      #pragma unroll
      for(int d0=0;d0<2;++d0)stg[orow*64+d0*32+r32]=__float2bfloat16(o[d0][r]*rli[r]);}
    asm volatile("s_waitcnt lgkmcnt(0)":::"memory");
    #pragma unroll
    for(int i=0;i<4;++i){const int row=i*8+(lane>>3),ch=lane&7; const u32x4 v=*(const u32x4*)(stg+row*64+ch*8); ATTN_STORE16(Ow+(long)row*OP+ch*8,v);} }
  asm volatile("s_waitcnt lgkmcnt(0)\n\ts_barrier":::"memory");
  #undef DMA_K
  #undef TMAP
  #undef DMA_V
  #undef CMASK
  #undef START
  #undef RESC
  #undef ROT
}
constexpr int ATTN_LDS_BYTES=LDS_BYTES;
#undef SBAR
#undef WAIT_BAR
}

constexpr int DM = 1024, SEQ = 2048, NBAT = 8, MP = NBAT * SEQ;
constexpr int MS = 128, DBAT = 32, DSEQ = 4, NPAGES = 64;
constexpr int NIN = 2560, FF = 4096, DPLE = 256;
constexpr float EPS = 1e-6f;
constexpr float C2 = 0.125f * 1.4426950408889634f;
constexpr size_t O_YP = 0, O_YS = 16777216, O_KP = 16908288, O_VP = 25296896, O_KS = 33685504, O_VS = 33751040, O_AV = 33816576, O_END = 33882112;
constexpr size_t MiB = 1u << 20;
constexpr size_t WS_CTL = 0, CTL_ZERO_BYTES = 1 * MiB;
constexpr size_t WS_WIN = 2 * MiB, WS_WOUT = 8 * MiB, WS_WUP = 10 * MiB, WS_WDN = 18 * MiB, WS_WPG = 26 * MiB, WS_WPP = 28 * MiB, WS_WTRIL = 29 * MiB;
constexpr size_t WS_KMP = 30 * MiB, WS_KMS = 31 * MiB, WS_SS2 = 34 * MiB, WS_SS3 = 35 * MiB, WS_SSE = 36 * MiB;
constexpr size_t WS_XNS = 40 * MiB, WS_PBS = 41 * MiB, WS_US = 42 * MiB, WS_VAS = 43 * MiB, WS_QS = 44 * MiB, WS_MIXS = 45 * MiB, WS_H1BS = 46 * MiB, WS_HBS = 47 * MiB, WS_H2BS = 48 * MiB, WS_ERS = 49 * MiB,
                 WS_SS2S = 50 * MiB, WS_SS3S = 51 * MiB, WS_SSES = 52 * MiB, WS_H2FS = 53 * MiB;
constexpr size_t WS_XN = 64 * MiB, WS_PB = 96 * MiB, WS_U = 104 * MiB, WS_VA = 120 * MiB, WS_Q = 136 * MiB, WS_K = 152 * MiB, WS_V = 168 * MiB, WS_MIX = 184 * MiB, WS_H1B = 216 * MiB, WS_H2B = 248 * MiB,
                 WS_ER = 280 * MiB, WS_HB = 312 * MiB, WS_H2F = 440 * MiB, WS_END = 504 * MiB;
constexpr int CW_BAR = 4096;
constexpr int SCR_BYTES = 139264;
constexpr int RS0_OFF = SCR_BYTES, RS1_OFF = RS0_OFF + 1024, MISC_OFF = RS1_OFF + 1024;
constexpr int LDS_BYTES = 147456;
constexpr int NWAVES = 8, NTHR = 512;
static_assert(MISC_OFF + 256 <= LDS_BYTES, "LDS map");

struct Args { const float* in[22]; float* out; unsigned char* ws; int ph_lo, ph_hi, li, pad; };
enum { I_XP = 0, I_XS, I_PP, I_PS, I_CK, I_CV, I_PT, I_LN1, I_WIN, I_AVN, I_AWS, I_ABS, I_QN, I_KN, I_WOUT, I_LN2, I_WUP, I_WDN, I_LN3, I_WPG, I_WPP, I_PLN };

__device__ __forceinline__ int perm_in(int L) { return (L & ~255) | (((L >> 5) & 1) << 7) | (((L >> 6) & 3) << 5) | (L & 31); }
__device__ __forceinline__ float wave_sum(float v) {
#pragma unroll
    for (int o = 1; o < 64; o <<= 1) v += __shfl_xor(v, o);
    return v;
}
__device__ __forceinline__ float wave_max(float v) {
#pragma unroll
    for (int o = 1; o < 64; o <<= 1) v = fmaxf(v, __shfl_xor(v, o));
    return v;
}
__device__ __forceinline__ float bfu(unsigned short h) { return __uint_as_float((unsigned)h << 16); }

__device__ __forceinline__ void transpose_item(const float* W, int K, int N, bf16* WT, int out_row0, const float* kscale, LAS float* scr, int k0, int n0, int lane) {
#pragma unroll 8
    for (int i = 0; i < 32; ++i) { const int kk = 2 * i + (lane >> 5); float v = W[(size_t)(k0 + kk) * N + n0 + (lane & 31)]; if (kscale) v *= kscale[k0 + kk]; scr[kk * 33 + (lane & 31)] = v; }
    LDS_WAIT(); asm volatile("" ::: "memory");
    const int c = lane & 7;
#pragma unroll
    for (int j = 0; j < 4; ++j) { const int n = (lane >> 3) + 8 * j; const LAS float* s = scr + (8 * c) * 33 + n;
        v4u o; o.x = pk2(s[0 * 33], s[1 * 33]); o.y = pk2(s[2 * 33], s[3 * 33]); o.z = pk2(s[4 * 33], s[5 * 33]); o.w = pk2(s[6 * 33], s[7 * 33]);
        *(v4u*)(WT + (size_t)(out_row0 + n) * K + k0 + 8 * c) = o; }
    LDS_WAIT(); asm volatile("" ::: "memory");
}
__device__ __forceinline__ void rms_row_to_bf16(const float* xrow, const float* gain, bf16* orow, int lane) {
    const f32x4* xr = (const f32x4*)xrow + lane; const f32x4* gr = (const f32x4*)gain + lane;
    f32x4 v[4]; float s = 0.f;
#pragma unroll
    for (int j = 0; j < 4; ++j) { v[j] = xr[64 * j]; s += (v[j].x * v[j].x + v[j].y * v[j].y) + (v[j].z * v[j].z + v[j].w * v[j].w); }
    const float rstd = 1.0f / sqrtf(wave_sum(s) * (1.0f / 1024.0f) + EPS);
    unsigned long long* o8 = (unsigned long long*)orow + lane;
#pragma unroll
    for (int j = 0; j < 4; ++j) { const f32x4 g = gr[64 * j]; o8[64 * j] = (unsigned long long)pk2(v[j].x * rstd * g.x, v[j].y * rstd * g.y) | ((unsigned long long)pk2(v[j].z * rstd * g.z, v[j].w * rstd * g.w) << 32); }
}

template <bool PERMUTED, class Epi>
__device__ __forceinline__ void thin_unit(LAS unsigned char* lds, const bf16* A, int lda, const bf16* Bt, int ldb, int K, int rh, int ct, const Epi& epi) {
    const int tid = threadIdx.x, lane = tid & 63, w = __builtin_amdgcn_readfirstlane(tid >> 6), fr = lane & 15, fq = lane >> 4;
    const int ks = K >> 3, kbeg = w * ks;
    f32x4 acc[4][4];
#pragma unroll
    for (int nt = 0; nt < 4; ++nt)
#pragma unroll
        for (int mt = 0; mt < 4; ++mt) acc[nt][mt] = (f32x4){0.f, 0.f, 0.f, 0.f};
    const bf16* ap = A + (size_t)(rh * 64 + fr) * lda + kbeg + 8 * fq;
    const bf16* bp[4];
#pragma unroll
    for (int nt = 0; nt < 4; ++nt) { const int L = 64 * ct + 16 * nt; const int p = PERMUTED ? perm_in(L) : L; bp[nt] = Bt + (size_t)(p + fr) * ldb + kbeg + 8 * fq; }
#pragma unroll 2
    for (int k = 0; k < ks; k += 32) {
        bf16x8 a[4], b[4];
#pragma unroll
        for (int mt = 0; mt < 4; ++mt) a[mt] = *(const bf16x8*)(ap + (size_t)mt * 16 * lda + k);
#pragma unroll
        for (int nt = 0; nt < 4; ++nt) b[nt] = *(const bf16x8*)(bp[nt] + k);
#pragma unroll
        for (int nt = 0; nt < 4; ++nt)
#pragma unroll
            for (int mt = 0; mt < 4; ++mt) acc[nt][mt] = __builtin_amdgcn_mfma_f32_16x16x32_bf16(b[nt], a[mt], acc[nt][mt], 0, 0, 0);
    }
    LAS float* red = (LAS float*)lds;
#pragma unroll
    for (int nt = 0; nt < 4; ++nt)
#pragma unroll
        for (int mt = 0; mt < 4; ++mt) *(LAS f32x4*)(red + w * (64 * 68) + (16 * mt + fr) * 68 + 16 * nt + 4 * fq) = acc[nt][mt];
    __syncthreads();
    const int row = tid >> 3, cg = tid & 7;
    float v[8];
#pragma unroll
    for (int e = 0; e < 8; ++e) v[e] = 0.f;
#pragma unroll
    for (int ww = 0; ww < 8; ++ww) { const f32x4 x0 = *(const LAS f32x4*)(red + ww * (64 * 68) + row * 68 + 8 * cg), x1 = *(const LAS f32x4*)(red + ww * (64 * 68) + row * 68 + 8 * cg + 4);
#pragma unroll
        for (int e = 0; e < 4; ++e) { v[e] += x0[e]; v[4 + e] += x1[e]; } }
    epi(rh * 64 + row, ct, cg, v);
    __syncthreads();
}
__device__ __forceinline__ void st_bf8(bf16* p, const float (&v)[8]) { v4u o; o.x = pk2(v[0], v[1]); o.y = pk2(v[2], v[3]); o.z = pk2(v[4], v[5]); o.w = pk2(v[6], v[7]); *(v4u*)p = o; }
__device__ __forceinline__ void st_f8(float* p, const float (&v)[8]) { *(f32x4*)p = (f32x4){v[0], v[1], v[2], v[3]}; *(f32x4*)(p + 4) = (f32x4){v[4], v[5], v[6], v[7]}; }
__device__ __forceinline__ float sum8sq(const float (&v)[8]) { float s = 0.f;
#pragma unroll
    for (int e = 0; e < 8; ++e) s += v[e] * v[e]; return s; }
__device__ __forceinline__ float red8(float s) { s += __shfl_xor(s, 1); s += __shfl_xor(s, 2); s += __shfl_xor(s, 4); return s; }

__device__ __forceinline__ void gate_prompt_unit(LAS unsigned char* lds, const bf16* VA, const bf16* U, const bf16* WTRIL, const float* avn, const float* abs_, bf16* MIX, int b, int c, int g) {
    const int tid = threadIdx.x, lane = tid & 63, wv = __builtin_amdgcn_readfirstlane(tid >> 6), fr = lane & 15, fq = lane >> 4;
    const size_t tok0 = (size_t)b * SEQ + (size_t)c * 128;
    LAS bf16* VT = (LAS bf16*)lds;
    { const int r = tid >> 2, qd = tid & 3; const bf16* src = VA + (tok0 + r) * 512 + g * 128 + 32 * qd;
      v4u x[4]; float ss = 0.f;
#pragma unroll
      for (int i = 0; i < 4; ++i) x[i] = *(const v4u*)(src + 8 * i);
      float f[32];
#pragma unroll
      for (int i = 0; i < 4; ++i) { f[8 * i + 0] = __uint_as_float(x[i].x << 16); f[8 * i + 1] = __uint_as_float(x[i].x & 0xffff0000u); f[8 * i + 2] = __uint_as_float(x[i].y << 16); f[8 * i + 3] = __uint_as_float(x[i].y & 0xffff0000u);
          f[8 * i + 4] = __uint_as_float(x[i].z << 16); f[8 * i + 5] = __uint_as_float(x[i].z & 0xffff0000u); f[8 * i + 6] = __uint_as_float(x[i].w << 16); f[8 * i + 7] = __uint_as_float(x[i].w & 0xffff0000u); }
#pragma unroll
      for (int i = 0; i < 32; ++i) ss += f[i] * f[i];
      ss += __shfl_xor(ss, 1); ss += __shfl_xor(ss, 2);
      const float rstd = 1.0f / sqrtf(ss * (1.0f / 128.0f) + EPS);
#pragma unroll
      for (int i = 0; i < 32; ++i) { const int w = 32 * qd + i; VT[w * 136 + r] = (bf16)f2bf(f[i] * rstd * avn[g * 128 + w]); }
    }
    __syncthreads();
    f32x4 acc[8];
#pragma unroll
    for (int wt = 0; wt < 8; ++wt) acc[wt] = (f32x4){0.f, 0.f, 0.f, 0.f};
#pragma unroll
    for (int ks = 0; ks < 4; ++ks) {
        if (32 * ks <= 16 * wv + 15) {
            const bf16x8 bw = *(const bf16x8*)(WTRIL + ((size_t)g * 128 + 16 * wv + fr) * 128 + 32 * ks + 8 * fq);
#pragma unroll
            for (int wt = 0; wt < 8; ++wt) { const bf16x8 av = *(const LAS bf16x8*)(VT + (16 * wt + fr) * 136 + 32 * ks + 8 * fq);
                acc[wt] = __builtin_amdgcn_mfma_f32_16x16x32_bf16(av, bw, acc[wt], 0, 0, 0); }
        }
    }
    { const int t = 16 * wv + fr; const size_t tok = tok0 + t; const float bias = abs_[g * 128 + t];
#pragma unroll
      for (int wt = 0; wt < 8; ++wt) { const int w0 = 16 * wt + 4 * fq; const u32x2 uw = *(const u32x2*)(U + tok * 512 + g * 128 + w0); const f32x4 uf = pg8::bf4_to_f32(uw);
          u32x2 o; o.x = pk2(uf[0] * (acc[wt][0] + bias), uf[1] * (acc[wt][1] + bias)); o.y = pk2(uf[2] * (acc[wt][2] + bias), uf[3] * (acc[wt][3] + bias));
          *(u32x2*)(MIX + tok * 1024 + g * 128 + w0) = o; } }
    __syncthreads();
}
__device__ __forceinline__ void gate_sample_unit(LAS unsigned char* lds, const float* VAS, const float* US, const float* aws, const float* avn, const float* abs_, bf16* MIXS, float* av_out, int b) {
    const int tid = threadIdx.x, lane = tid & 63, wv = tid >> 6, g = tid >> 7;
    LAS float* red = (LAS float*)lds;
    float v[4], ss[4];
#pragma unroll
    for (int s = 0; s < 4; ++s) { v[s] = VAS[(size_t)(4 * b + s) * 512 + tid]; ss[s] = wave_sum(v[s] * v[s]); }
    if (lane == 0) {
#pragma unroll
        for (int s = 0; s < 4; ++s) red[wv * 4 + s] = ss[s]; }
    __syncthreads();
    const float gain = avn[tid];
#pragma unroll
    for (int s = 0; s < 4; ++s) { const float tot = red[(2 * g) * 4 + s] + red[(2 * g + 1) * 4 + s]; v[s] = v[s] * (1.0f / sqrtf(tot * (1.0f / 128.0f) + EPS)) * gain; av_out[(size_t)(4 * b + s) * 512 + tid] = v[s]; }
#pragma unroll
    for (int t = 0; t < 4; ++t) { float sg = abs_[g * 128 + t];
#pragma unroll
        for (int s = 0; s < 4; ++s) if (s <= t) sg += aws[((size_t)g * 128 + t) * 128 + s] * v[s];
        MIXS[(size_t)(4 * b + t) * 1024 + tid] = (bf16)f2bf(US[(size_t)(4 * b + t) * 512 + tid] * sg); }
    __syncthreads();
}
__device__ __forceinline__ void moba_prompt_simple(LAS unsigned char* lds, const bf16* Q, const bf16* K, const bf16* V, const float* KMP, bf16* MIX, int b, int hp, int qb) {
    const int tid = threadIdx.x, hl = tid >> 8, qi = tid & 255, h = 2 * hp + hl;
    const size_t row = (size_t)b * SEQ + (size_t)qb * 256 + qi;
    LAS float* km = (LAS float*)lds;
    LAS bf16* kt = (LAS bf16*)(lds + 4096);
    LAS bf16* vt = (LAS bf16*)(lds + 4096 + 16384);
    float q[64];
    { const v4u* qp = (const v4u*)(Q + row * 512 + h * 64);
#pragma unroll
      for (int i = 0; i < 8; ++i) { const v4u x = qp[i]; q[8 * i + 0] = __uint_as_float(x.x << 16); q[8 * i + 1] = __uint_as_float(x.x & 0xffff0000u); q[8 * i + 2] = __uint_as_float(x.y << 16); q[8 * i + 3] = __uint_as_float(x.y & 0xffff0000u);
          q[8 * i + 4] = __uint_as_float(x.z << 16); q[8 * i + 5] = __uint_as_float(x.z & 0xffff0000u); q[8 * i + 6] = __uint_as_float(x.w << 16); q[8 * i + 7] = __uint_as_float(x.w & 0xffff0000u); } }
    for (int idx = tid; idx < 1024; idx += NTHR) { const int hh = idx >> 9, j = (idx >> 6) & 7, d = idx & 63; float val = 0.f;
        if (j < qb) { const int pm = b * 8 + j, col = (2 * hp + hh) * 64 + d; val = (KMP[(size_t)(pm * 2) * 512 + col] + KMP[(size_t)(pm * 2 + 1) * 512 + col]) * (1.0f / 256.0f); }
        km[idx] = val; }
    __syncthreads();
    unsigned sel = 0;
    { float gsc[8];
#pragma unroll
      for (int j = 0; j < 8; ++j) { float s = 0.f;
#pragma unroll
          for (int d = 0; d < 64; ++d) s += q[d] * km[(hl * 8 + j) * 64 + d];
          gsc[j] = s; }
#pragma unroll
      for (int j = 0; j < 8; ++j) { int rank = 0;
#pragma unroll
          for (int i = 0; i < 8; ++i) if (i != j && i < qb && (gsc[i] > gsc[j] || (gsc[i] == gsc[j] && i < j))) ++rank;
          if (j < qb && rank < 3) sel |= 1u << j; } }
    float o[64], m = 0.f, l = 0.f; bool first = true;
#pragma unroll
    for (int d = 0; d < 64; ++d) o[d] = 0.f;
    for (int kb = 0; kb <= qb; ++kb)
        for (int t = 0; t < 4; ++t) {
            __syncthreads();
            { const size_t krow0 = (size_t)b * SEQ + (size_t)kb * 256 + t * 64;
#pragma unroll
              for (int i = 0; i < 2; ++i) { const int ch = tid + i * NTHR, r = ch >> 4, cc = ch & 15;
                  *(LAS v4u*)(kt + r * 128 + cc * 8) = *(const v4u*)(K + (krow0 + r) * 512 + hp * 128 + cc * 8);
                  *(LAS v4u*)(vt + r * 128 + cc * 8) = *(const v4u*)(V + (krow0 + r) * 512 + hp * 128 + cc * 8); } }
            __syncthreads();
            const bool own = (kb == qb);
            const bool act = own ? (t * 64 <= qi) : (((sel >> kb) & 1u) != 0u);
            if (act) {
                const int nk = own ? min(64, qi - t * 64 + 1) : 64;
                for (int kk = 0; kk < nk; ++kk) {
                    float s = 0.f;
#pragma unroll
                    for (int i = 0; i < 8; ++i) { const v4u x = *(const LAS v4u*)(kt + kk * 128 + hl * 64 + 8 * i);
                        s += q[8 * i + 0] * __uint_as_float(x.x << 16) + q[8 * i + 1] * __uint_as_float(x.x & 0xffff0000u) + q[8 * i + 2] * __uint_as_float(x.y << 16) + q[8 * i + 3] * __uint_as_float(x.y & 0xffff0000u)
                           + q[8 * i + 4] * __uint_as_float(x.z << 16) + q[8 * i + 5] * __uint_as_float(x.z & 0xffff0000u) + q[8 * i + 6] * __uint_as_float(x.w << 16) + q[8 * i + 7] * __uint_as_float(x.w & 0xffff0000u); }
                    if (first) { m = s; first = false; }
                    if (s > m + 8.0f) { const float f = __builtin_amdgcn_exp2f(m - s); l *= f;
#pragma unroll
                        for (int d = 0; d < 64; ++d) o[d] *= f;
                        m = s; }
                    const float p = __builtin_amdgcn_exp2f(s - m); l += p;
#pragma unroll
                    for (int i = 0; i < 8; ++i) { const v4u x = *(const LAS v4u*)(vt + kk * 128 + hl * 64 + 8 * i);
                        o[8 * i + 0] += p * __uint_as_float(x.x << 16); o[8 * i + 1] += p * __uint_as_float(x.x & 0xffff0000u); o[8 * i + 2] += p * __uint_as_float(x.y << 16); o[8 * i + 3] += p * __uint_as_float(x.y & 0xffff0000u);
                        o[8 * i + 4] += p * __uint_as_float(x.z << 16); o[8 * i + 5] += p * __uint_as_float(x.z & 0xffff0000u); o[8 * i + 6] += p * __uint_as_float(x.w << 16); o[8 * i + 7] += p * __uint_as_float(x.w & 0xffff0000u); }
                }
            }
        }
    { const float rl = 1.0f / l; bf16* op = MIX + row * 1024 + 512 + h * 64;
#pragma unroll
      for (int i = 0; i < 8; ++i) { v4u w; w.x = pk2(o[8 * i] * rl, o[8 * i + 1] * rl); w.y = pk2(o[8 * i + 2] * rl, o[8 * i + 3] * rl); w.z = pk2(o[8 * i + 4] * rl, o[8 * i + 5] * rl); w.w = pk2(o[8 * i + 6] * rl, o[8 * i + 7] * rl); *(v4u*)(op + 8 * i) = w; } }
    __syncthreads();
}
__device__ __forceinline__ void moba_sample_unit(LAS unsigned char* lds, const float* QS, const float* ksn, const float* vsn, const float* ck, const float* cv, const int* pt, const float* KMS, bf16* MIXS, int b, int h, int i) {
    const int tid = threadIdx.x, lane = tid & 63, wv = __builtin_amdgcn_readfirstlane(tid >> 6), c = lane & 15, kq = lane >> 4;
    LAS float* sc = (LAS float*)lds;
    LAS float* redv = (LAS float*)(lds + 4096);
    const float* qrow = QS + (size_t)(4 * b + i) * 512 + h * 64;
    int s3[3];
    { const float* kmrow = KMS + ((size_t)b * 32 + (lane & 31)) * 512 + h * 64; float g = 0.f;
#pragma unroll
      for (int d = 0; d < 16; ++d) g += pg8::dot4(*(const f32x4*)(qrow + 4 * d), *(const f32x4*)(kmrow + 4 * d));
#pragma unroll
      for (int r = 0; r < 3; ++r) { const float m = wave_max(g); const unsigned long long mk = __ballot(g == m); const int idx = (__ffsll((long long)mk) - 1) & 31; s3[r] = __builtin_amdgcn_readfirstlane(idx); if ((lane & 31) == s3[r]) g = -INFINITY; } }
    int pgid[6];
#pragma unroll
    for (int r = 0; r < 3; ++r) { pgid[2 * r] = __builtin_amdgcn_readfirstlane(pt[b * NPAGES + 2 * s3[r]]); pgid[2 * r + 1] = __builtin_amdgcn_readfirstlane(pt[b * NPAGES + 2 * s3[r] + 1]); }
    const f32x4 q4 = *(const f32x4*)(qrow + 4 * c);
    const size_t lofs = (size_t)(16 * wv + kq) * 512 + h * 64 + 4 * c;
    f32x4 kr[24];
#pragma unroll
    for (int p = 0; p < 6; ++p)
#pragma unroll
        for (int it = 0; it < 4; ++it) kr[p * 4 + it] = __builtin_nontemporal_load((const f32x4*)(ck + (size_t)pgid[p] * (128 * 512) + lofs + (size_t)it * (4 * 512)));
    f32x4 knew = (f32x4){0.f, 0.f, 0.f, 0.f}, vnew = knew;
    const bool newk = (wv == 0 && kq <= i);
    if (newk) { knew = *(const f32x4*)(ksn + (size_t)(4 * b + kq) * 512 + h * 64 + 4 * c); vnew = *(const f32x4*)(vsn + (size_t)(4 * b + kq) * 512 + h * 64 + 4 * c); }
#pragma unroll
    for (int p = 0; p < 6; ++p)
#pragma unroll
        for (int it = 0; it < 4; ++it) { float d = pg8::dot4(q4, kr[p * 4 + it]); d += __shfl_xor(d, 1); d += __shfl_xor(d, 2); d += __shfl_xor(d, 4); d += __shfl_xor(d, 8);
            if (c == 0) sc[p * 128 + 16 * wv + 4 * it + kq] = d * 0.125f; }
    if (newk) { float d = pg8::dot4(q4, knew); d += __shfl_xor(d, 1); d += __shfl_xor(d, 2); d += __shfl_xor(d, 4); d += __shfl_xor(d, 8); if (c == 0) sc[768 + kq] = d * 0.125f; }
    f32x4 vr[24];
#pragma unroll
    for (int p = 0; p < 6; ++p)
#pragma unroll
        for (int it = 0; it < 4; ++it) vr[p * 4 + it] = __builtin_nontemporal_load((const f32x4*)(cv + (size_t)pgid[p] * (128 * 512) + lofs + (size_t)it * (4 * 512)));
    __syncthreads();
    const int n = 768 + i + 1;
    float mx = -INFINITY;
    for (int k2 = lane; k2 < n; k2 += 64) mx = fmaxf(mx, sc[k2]);
    mx = wave_max(mx);
    f32x4 a4 = (f32x4){0.f, 0.f, 0.f, 0.f}; float ps = 0.f;
#pragma unroll
    for (int p = 0; p < 6; ++p)
#pragma unroll
        for (int it = 0; it < 4; ++it) { const float pr = __builtin_amdgcn_exp2f((sc[p * 128 + 16 * wv + 4 * it + kq] - mx) * 1.4426950408889634f); a4 += vr[p * 4 + it] * pr; ps += pr; }
    if (newk) { const float pr = __builtin_amdgcn_exp2f((sc[768 + kq] - mx) * 1.4426950408889634f); a4 += vnew * pr; ps += pr; }
#pragma unroll
    for (int e = 0; e < 4; ++e) { float x = a4[e]; x += __shfl_xor(x, 16); x += __shfl_xor(x, 32); a4[e] = x; }
    ps += __shfl_xor(ps, 16); ps += __shfl_xor(ps, 32);
    if (kq == 0) { *(LAS f32x4*)(redv + wv * 80 + 4 * c) = a4; if (c == 0) redv[wv * 80 + 64] = ps; }
    __syncthreads();
    if (tid < 64) { float s = 0.f, l = 0.f;
#pragma unroll
        for (int w2 = 0; w2 < 8; ++w2) { s += redv[w2 * 80 + tid]; l += redv[w2 * 80 + 64]; }
        MIXS[(size_t)(4 * b + i) * 1024 + 512 + h * 64 + tid] = (bf16)f2bf(s / l); }
    __syncthreads();
}
struct EOrder {
    int c, nu;
    __device__ __forceinline__ bool next(int i, pg8::Unit& u) const { if (c < 128 || i >= nu) return false; u.pm = 8 * (c % 8) + (c / 8) % 8; u.pn = 2 * (c / 64 - 2) + i; return true; }
    __device__ __forceinline__ void a_ready(const pg8::Unit&) const {}
    __device__ __forceinline__ void done(const pg8::Unit&) const {}
};

#ifndef MK_N_LAUNCHES
#define MK_N_LAUNCHES 1
#endif
#ifndef PROBE_DUP
#define PROBE_DUP -1
#endif
constexpr int N_PHASES = 7;

__global__ void __launch_bounds__(NTHR, 2) fwd(Args args) {
    extern __shared__ __attribute__((aligned(16))) unsigned char lds_raw[];
    LAS unsigned char* lds = (LAS unsigned char*)lds_raw;
    volatile LAS unsigned* MISC = (volatile LAS unsigned*)(lds + MISC_OFF);
    const int tid = threadIdx.x, lane = tid & 63, wave = __builtin_amdgcn_readfirstlane(tid >> 6);
    const int G = gridDim.x, bx = blockIdx.x, vcu = (G % 8 == 0) ? (bx % 8) * (G / 8) + bx / 8 : bx;
    unsigned char* ws = args.ws;
    unsigned* ctl = (unsigned*)(ws + WS_CTL);
    float* out = args.out;
    for (int u = tid; u < (LDS_BYTES - SCR_BYTES) / 4; u += NTHR) ((LAS unsigned*)(lds + SCR_BYTES))[u] = 0u;
    __syncthreads();
    XcdBarrier bar; bar.bar = ctl + CW_BAR; bar.x = 0; bar.st = nullptr;
    if (MK_N_LAUNCHES == 1) bar = xcd_barrier_post(ctl + CW_BAR + args.li * XCD_BAR_WORDS, MISC + 8);
#define GRID_BAR() do { if (MK_N_LAUNCHES == 1) xcd_barrier(bar); } while (0)
    const int lo = args.ph_lo, hi = args.ph_hi;
#ifndef PH_MASK
#define PH_MASK 0x7f
#endif
#define IN(k) (((PH_MASK >> (k)) & 1) && lo <= (k) && (k) < hi)
#define BOTH(k) (IN(k) && IN((k) + 1))
    bf16* WIN = (bf16*)(ws + WS_WIN); bf16* WOUT = (bf16*)(ws + WS_WOUT); bf16* WUP = (bf16*)(ws + WS_WUP); bf16* WDN = (bf16*)(ws + WS_WDN); bf16* WPG = (bf16*)(ws + WS_WPG); bf16* WPP = (bf16*)(ws + WS_WPP);
    bf16* WTRIL = (bf16*)(ws + WS_WTRIL);
    float* KMP = (float*)(ws + WS_KMP); float* KMS = (float*)(ws + WS_KMS); float* SS2 = (float*)(ws + WS_SS2); float* SS3 = (float*)(ws + WS_SS3); float* SSE = (float*)(ws + WS_SSE);
    bf16* XNS = (bf16*)(ws + WS_XNS); bf16* PBS = (bf16*)(ws + WS_PBS); float* US = (float*)(ws + WS_US); float* VAS = (float*)(ws + WS_VAS); float* QS = (float*)(ws + WS_QS);
    bf16* MIXS = (bf16*)(ws + WS_MIXS); bf16* H1BS = (bf16*)(ws + WS_H1BS); bf16* HBS = (bf16*)(ws + WS_HBS); bf16* H2BS = (bf16*)(ws + WS_H2BS); float* ERS = (float*)(ws + WS_ERS);
    float* SS2S = (float*)(ws + WS_SS2S); float* SS3S = (float*)(ws + WS_SS3S); float* SSES = (float*)(ws + WS_SSES);
    bf16* XN = (bf16*)(ws + WS_XN); bf16* PB = (bf16*)(ws + WS_PB); bf16* U = (bf16*)(ws + WS_U); bf16* VA = (bf16*)(ws + WS_VA); bf16* Q = (bf16*)(ws + WS_Q); bf16* K = (bf16*)(ws + WS_K); bf16* V = (bf16*)(ws + WS_V);
    bf16* MIX = (bf16*)(ws + WS_MIX); bf16* H1B = (bf16*)(ws + WS_H1B); bf16* H2B = (bf16*)(ws + WS_H2B); bf16* ER = (bf16*)(ws + WS_ER); bf16* HB = (bf16*)(ws + WS_HB); float* H2F = (float*)(ws + WS_H2F); float* H2FS = (float*)(ws + WS_H2FS);
    LAS float* RS0 = (LAS float*)(lds + RS0_OFF); LAS float* RS1 = (LAS float*)(lds + RS1_OFF);
    const int gw = vcu * NWAVES + wave, NGW = G * NWAVES;
    const int my_pm = 8 * (bx % 8) + (bx / 8) % 8;

    if (IN(0)) {
        LAS float* scr = (LAS float*)(lds + wave * 16384);
        constexpr int T_IN = 16 * 80, T_OUT = 16 * 32, T_UP = 16 * 128, T_DN = 64 * 32, T_PG = 16 * 32, T_PP = 4 * 32, NITEMS = T_IN + T_OUT + T_UP + T_DN + T_PG + T_PP;
        for (int it = gw; it < NITEMS; it += NGW) {
            int r = it;
            if (r < T_IN) { const int kb = r / 80, nb = r % 80; transpose_item(args.in[I_WIN], DM, NIN, WIN, perm_in(32 * nb), nullptr, scr, 64 * kb, 32 * nb, lane); continue; } r -= T_IN;
            if (r < T_OUT) { const int kb = r / 32, nb = r % 32; transpose_item(args.in[I_WOUT], DM, DM, WOUT, 32 * nb, nullptr, scr, 64 * kb, 32 * nb, lane); continue; } r -= T_OUT;
            if (r < T_UP) { const int kb = r / 128, nb = r % 128; transpose_item(args.in[I_WUP], DM, FF, WUP, 32 * nb, args.in[I_LN2], scr, 64 * kb, 32 * nb, lane); continue; } r -= T_UP;
            if (r < T_DN) { const int kb = r / 32, nb = r % 32; transpose_item(args.in[I_WDN], FF, DM, WDN, 32 * nb, nullptr, scr, 64 * kb, 32 * nb, lane); continue; } r -= T_DN;
            if (r < T_PG) { const int kb = r / 32, nb = r % 32; transpose_item(args.in[I_WPG], DM, DM, WPG, 32 * nb, args.in[I_LN3], scr, 64 * kb, 32 * nb, lane); continue; } r -= T_PG;
            { const int kb = r / 32, nb = r % 32; transpose_item(args.in[I_WPP], DPLE, DM, WPP, 32 * nb, nullptr, scr, 64 * kb, 32 * nb, lane); }
        }
        for (int e = gw * 64 + lane; e < 4 * 128 * 128; e += NGW * 64) { const int t = (e >> 7) & 127, s = e & 127; WTRIL[e] = (bf16)(s <= t ? f2bf(args.in[I_AWS][e]) : 0u); }
        for (int m = gw; m < MP + MS; m += NGW) {
            if (m < MP) rms_row_to_bf16(args.in[I_XP] + (size_t)m * DM, args.in[I_LN1], XN + (size_t)m * DM, lane);
            else rms_row_to_bf16(args.in[I_XS] + (size_t)(m - MP) * DM, args.in[I_LN1], XNS + (size_t)(m - MP) * DM, lane);
        }
        for (int e = gw * 64 + lane; e < (MP + MS) * DPLE / 8; e += NGW * 64) {
            const bool sm = e >= MP * DPLE / 8; const int ee = sm ? e - MP * DPLE / 8 : e;
            const float* src = (sm ? args.in[I_PS] : args.in[I_PP]) + (size_t)ee * 8; bf16* dst = (sm ? PBS : PB) + (size_t)ee * 8;
            const f32x4 a = *(const f32x4*)src, b = *(const f32x4*)(src + 4); v4u o; o.x = pk2(a.x, a.y); o.y = pk2(a.z, a.w); o.z = pk2(b.x, b.y); o.w = pk2(b.z, b.w); *(v4u*)dst = o;
        }
        { const int* pt = (const int*)args.in[I_PT]; const float* ck = args.in[I_CK]; LAS f32x4* red = (LAS f32x4*)lds;
          __syncthreads();
          for (int un = vcu; un < DBAT * 32; un += G) { const int b = un >> 5, j = un & 31; const int p0 = pt[b * NPAGES + 2 * j], p1 = pt[b * NPAGES + 2 * j + 1];
              const int cgp = tid & 127, ph = tid >> 7; f32x4 a = (f32x4){0.f, 0.f, 0.f, 0.f};
#pragma unroll 16
              for (int r = 0; r < 64; ++r) { const int rw = ph + 4 * r; const int page = rw < 128 ? p0 : p1;
                  a += __builtin_nontemporal_load((const f32x4*)(ck + ((size_t)page * 128 + (rw & 127)) * 512 + 4 * cgp)); }
              red[ph * 128 + cgp] = a;
              __syncthreads();
              if (tid < 128) { const f32x4 s = (red[tid] + red[128 + tid]) + (red[256 + tid] + red[384 + tid]); *(f32x4*)(KMS + (size_t)un * 512 + 4 * tid) = s * (1.0f / 256.0f); }
              __syncthreads(); } }
        if (BOTH(0)) GRID_BAR();
    }

    if (IN(1)) {
#ifndef P1M
#define P1M 7
#endif
        if (P1M & 1) { pg8::Gemm g{XN, WIN, MP, NIN, DM}; pg8::StaticOrder S; S.init(MP, NIN, G, bx);
          pg8::EpiIn E{U, VA, Q, K, V, out + O_KP, out + O_VP, KMP, args.in[I_QN], args.in[I_KN], C2, EPS};
          pg8::gemm_phase<pg8::EpiIn, pg8::StaticOrder, true, true>(lds, g, S, E); }
        __syncthreads();
        if (P1M & 2) { int two, kple; asm volatile("s_mov_b32 %0, 2" : "=s"(two)); asm volatile("s_mov_b32 %0, 256" : "=s"(kple)); pg8::Gemm g{PB, WPP, MP, DM, kple};
          EOrder S{bx, two}; pg8::EpiE E{ER, SSE};
          pg8::gemm_phase<pg8::EpiE, EOrder, true, true>(lds, g, S, E); }
        __syncthreads();
        if (P1M & 4) { const float* qn = args.in[I_QN]; const float* kn = args.in[I_KN]; float* kso = out + O_KS; float* vso = out + O_VS;
          auto epi_in = [=](int row, int ct, int cg, float (&v)[8]) __attribute__((always_inline)) {
              const int sec = ct >> 3, cs = (ct & 7) * 64 + 8 * cg;
              if (sec == 0 || sec == 1) {
#pragma unroll
                  for (int e = 0; e < 8; ++e) v[e] = pg8::gelu_t(v[e]);
                  st_f8((float*)(ws + (sec == 0 ? WS_US : WS_VAS)) + (size_t)row * 512 + cs, v);
              } else if (sec == 4) { st_f8(vso + (size_t)row * 512 + cs, v); }
              else { const float ss = red8(sum8sq(v)); const float rstd = 1.0f / sqrtf(ss * (1.0f / 64.0f) + EPS);
                  if (sec == 2) {
#pragma unroll
                      for (int e = 0; e < 8; ++e) v[e] = v[e] * rstd * qn[8 * cg + e];
                      st_f8(QS + (size_t)row * 512 + cs, v);
                  } else {
#pragma unroll
                      for (int e = 0; e < 8; ++e) v[e] = v[e] * rstd * kn[8 * cg + e];
                      st_f8(kso + (size_t)row * 512 + cs, v); } } };
          auto epi_e = [=](int row, int ct, int cg, float (&v)[8]) __attribute__((always_inline)) { st_f8(ERS + (size_t)row * 1024 + 64 * ct + 8 * cg, v); const float ss = red8(sum8sq(v)); if (cg == 0) SSES[row * 16 + ct] = ss; };
          for (int un = G - 1 - bx; un < 80 + 32; un += G) {
              if (un < 80) thin_unit<true>(lds, XNS, DM, WIN, DM, DM, un / 40, un % 40, epi_in);
              else { const int e = un - 80; thin_unit<false>(lds, PBS, DPLE, WPP, DPLE, DPLE, e / 16, e % 16, epi_e); } } }
        if (BOTH(1)) GRID_BAR();
    }

    if (IN(2)) {
#if defined(MOBA_SIMPLE)
        for (int un = vcu; un < 256; un += G) { const int qb = 7 - (un >> 5), r = un & 31; moba_prompt_simple(lds, Q, K, V, KMP, MIX, r >> 2, r & 3, qb); }
#else
        for (int un = vcu; un < 256; un += G) { const int bh = un >> 2, s4 = un & 3;
#pragma unroll 1
            for (int i2 = 0; i2 < 2; ++i2)
                attn_body::attn_unit<8>(bh >> 3, bh & 7, i2 == 0 ? s4 : 7 - s4, (const attn_body::bf16*)Q, (const attn_body::bf16*)K, (const attn_body::bf16*)V, (attn_body::bf16*)MIX, KMP, (char*)lds_raw); }
        __syncthreads();
#endif
        for (int un = vcu; un < 512; un += G) gate_prompt_unit(lds, VA, U, WTRIL, args.in[I_AVN], args.in[I_ABS], MIX, un >> 6, (un >> 2) & 15, un & 3);
        for (int un = vcu; un < DBAT; un += G) gate_sample_unit(lds, VAS, US, args.in[I_AWS], args.in[I_AVN], args.in[I_ABS], MIXS, out + O_AV, un);
        for (int un = vcu; un < DBAT * 8 * DSEQ; un += G) moba_sample_unit(lds, QS, out + O_KS, out + O_VS, args.in[I_CK], args.in[I_CV], (const int*)args.in[I_PT], KMS, MIXS, un >> 5, (un >> 2) & 7, un & 3);
        if (BOTH(2)) GRID_BAR();
    }

    if (IN(3)) {
        { pg8::Gemm g{MIX, WOUT, MP, DM, DM}; pg8::StaticOrder S; S.init(MP, DM, G, bx); pg8::EpiRes<false> E{args.in[I_XP], H1B, SS2};
          pg8::gemm_phase<pg8::EpiRes<false>, pg8::StaticOrder, false, true>(lds, g, S, E); }
        __syncthreads();
        { const float* xs = args.in[I_XS]; float* ys = out + O_YS;
          auto epi = [=](int row, int ct, int cg, float (&v)[8]) __attribute__((always_inline)) { const size_t off = (size_t)row * 1024 + 64 * ct + 8 * cg; const f32x4 a = *(const f32x4*)(xs + off), b = *(const f32x4*)(xs + off + 4);
              v[0] += a.x; v[1] += a.y; v[2] += a.z; v[3] += a.w; v[4] += b.x; v[5] += b.y; v[6] += b.z; v[7] += b.w;
              st_f8(ys + off, v); st_bf8(H1BS + off, v); const float ss = red8(sum8sq(v)); if (cg == 0) SS2S[row * 16 + ct] = ss; };
          for (int un = G - 1 - bx; un < 32; un += G) thin_unit<false>(lds, MIXS, DM, WOUT, DM, DM, un / 16, un % 16, epi); }
        if (BOTH(3)) GRID_BAR();
    }

    if (IN(4)) {
        if (tid < 256) { const f32x4 s = *(const f32x4*)(SS2 + (size_t)(my_pm * 256 + tid) * 4); RS0[tid] = 1.0f / sqrtf(((s.x + s.y) + (s.z + s.w)) * (1.0f / 1024.0f) + EPS); }
        __syncthreads();
        { pg8::Gemm g{H1B, WUP, MP, FF, DM}; pg8::StaticOrder S; S.init(MP, FF, G, bx); pg8::EpiUp E{HB, RS0};
          pg8::gemm_phase<pg8::EpiUp, pg8::StaticOrder, true, true>(lds, g, S, E); }
        __syncthreads();
        { auto epi = [=](int row, int ct, int cg, float (&v)[8]) __attribute__((always_inline)) { float s = 0.f;
#pragma unroll
              for (int e = 0; e < 16; ++e) s += SS2S[row * 16 + e];
              const float r = 1.0f / sqrtf(s * (1.0f / 1024.0f) + EPS);
#pragma unroll
              for (int e = 0; e < 8; ++e) { const float a = fmaxf(v[e] * r, 0.f); v[e] = a * a; }
              st_bf8(HBS + (size_t)row * FF + 64 * ct + 8 * cg, v); };
          for (int un = G - 1 - bx; un < 128; un += G) thin_unit<false>(lds, H1BS, DM, WUP, DM, DM, un / 64, un % 64, epi); }
        if (BOTH(4)) GRID_BAR();
    }

    if (IN(5)) {
        { pg8::Gemm g{HB, WDN, MP, DM, FF}; pg8::StaticOrder S; S.init(MP, DM, G, bx); pg8::EpiRes<true> E{H1B, H2B, SS3};
          pg8::gemm_phase<pg8::EpiRes<true>, pg8::StaticOrder, false, true>(lds, g, S, E); }
        __syncthreads();
        { float* ys = out + O_YS;
          auto epi = [=](int row, int ct, int cg, float (&v)[8]) __attribute__((always_inline)) { const size_t off = (size_t)row * 1024 + 64 * ct + 8 * cg; const f32x4 a = *(const f32x4*)(ys + off), b = *(const f32x4*)(ys + off + 4);
              v[0] += a.x; v[1] += a.y; v[2] += a.z; v[3] += a.w; v[4] += b.x; v[5] += b.y; v[6] += b.z; v[7] += b.w;
              st_f8(H2FS + off, v); st_bf8(H2BS + off, v); const float ss = red8(sum8sq(v)); if (cg == 0) SS3S[row * 16 + ct] = ss; };
          for (int un = G - 1 - bx; un < 32; un += G) thin_unit<false>(lds, HBS, FF, WDN, FF, FF, un / 16, un % 16, epi); }
        if (BOTH(5)) GRID_BAR();
    }

    if (IN(6)) {
        if (tid < 256) { const size_t row = (size_t)my_pm * 256 + tid; const f32x4 s = *(const f32x4*)(SS3 + row * 4); RS0[tid] = 1.0f / sqrtf(((s.x + s.y) + (s.z + s.w)) * (1.0f / 1024.0f) + EPS);
            float se = 0.f;
#pragma unroll
            for (int e = 0; e < 4; ++e) { const f32x4 t4 = *(const f32x4*)(SSE + row * 16 + 4 * e); se += (t4.x + t4.y) + (t4.z + t4.w); }
            RS1[tid] = 1.0f / sqrtf(se * (1.0f / 1024.0f) + EPS); }
        __syncthreads();
        { pg8::Gemm g{H2B, WPG, MP, DM, DM}; pg8::StaticOrder S; S.init(MP, DM, G, bx); pg8::EpiPle E{H2B, out + O_YP, ER, args.in[I_PLN], RS0, RS1};
          pg8::gemm_phase<pg8::EpiPle, pg8::StaticOrder, false, true>(lds, g, S, E); }
        __syncthreads();
        { float* ys = out + O_YS; const float* pln = args.in[I_PLN];
          auto epi = [=](int row, int ct, int cg, float (&v)[8]) __attribute__((always_inline)) { float s = 0.f;
#pragma unroll
              for (int e = 0; e < 16; ++e) s += SS3S[row * 16 + e];
              const float r3 = 1.0f / sqrtf(s * (1.0f / 1024.0f) + EPS);
              float se = 0.f; const float* er = ERS + (size_t)row * 1024;
#pragma unroll
              for (int e = 0; e < 16; ++e) se += SSES[row * 16 + e];
              const float re = 1.0f / sqrtf(se * (1.0f / 1024.0f) + EPS);
              const size_t off = (size_t)row * 1024 + 64 * ct + 8 * cg;
#pragma unroll
              for (int e = 0; e < 8; ++e) { const float gt = 1.0f / (1.0f + __expf(-r3 * v[e])); v[e] = H2FS[off + e] + gt * (er[64 * ct + 8 * cg + e] * re * pln[64 * ct + 8 * cg + e]); }
              st_f8(ys + off, v); };
          for (int un = G - 1 - bx; un < 32; un += G) thin_unit<false>(lds, H2BS, DM, WPG, DM, DM, un / 16, un % 16, epi); }
    }
#undef IN
#undef BOTH
}

extern "C" void kernel_launch(void* const* d_in, const int* in_sizes, int n_in, void* d_out, int out_size, void* d_ws, size_t ws_size, hipStream_t stream) {
    static int grid = 0;
    if (grid == 0) {
        if (n_in != 22 || (size_t)out_size != O_END || ws_size < WS_END) { fprintf(stderr, "kernel_launch: unexpected problem shape (n_in %d, out %d, ws %zu); nothing launched\n", n_in, out_size, ws_size); grid = -1; return; }
        int dev = 0, cus = 0, per_cu = 0;
        if (hipGetDevice(&dev) != hipSuccess || hipDeviceGetAttribute(&cus, hipDeviceAttributeMultiprocessorCount, dev) != hipSuccess) { grid = -1; return; }
        if (hipFuncSetAttribute((const void*)fwd, hipFuncAttributeMaxDynamicSharedMemorySize, LDS_BYTES) != hipSuccess) { fprintf(stderr, "kernel_launch: hipFuncSetAttribute failed\n"); grid = -1; return; }
        if (hipOccupancyMaxActiveBlocksPerMultiprocessor(&per_cu, (const void*)fwd, NTHR, LDS_BYTES) != hipSuccess || per_cu < 1) fprintf(stderr, "kernel_launch: occupancy query reports %d\n", per_cu);
        (void)hipGetLastError();
        grid = cus;
        if (grid != 256) { fprintf(stderr, "kernel_launch: built for 256 CUs, found %d; nothing launched\n", cus); grid = -1; return; }
    }
    if (grid < 0) return;
    if (hipMemsetAsync((char*)d_ws + WS_CTL, 0, CTL_ZERO_BYTES, stream) != hipSuccess) return;
    Args a{};
    for (int i = 0; i < 22; ++i) a.in[i] = (const float*)d_in[i];
    a.out = (float*)d_out; a.ws = (unsigned char*)d_ws;
    if (PROBE_DUP >= 0) {
        a.ph_lo = 0; a.ph_hi = PROBE_DUP + 1; a.li = 0; hipLaunchKernelGGL(fwd, dim3(grid), dim3(NTHR), LDS_BYTES, stream, a);
        a.ph_lo = PROBE_DUP; a.ph_hi = N_PHASES; a.li = 1; hipLaunchKernelGGL(fwd, dim3(grid), dim3(NTHR), LDS_BYTES, stream, a);
        return;
    }
    for (int li = 0; li < MK_N_LAUNCHES; ++li) {
        a.ph_lo = (MK_N_LAUNCHES == 1) ? 0 : li; a.ph_hi = (MK_N_LAUNCHES == 1) ? N_PHASES : li + 1; a.li = 0;
        hipLaunchKernelGGL(fwd, dim3(grid), dim3(NTHR), LDS_BYTES, stream, a);
    }
}
```
